# Optimizing an MI355X kernel written in HIP

```python
import math
import jax, jax.numpy as jnp
from jax import lax
import numpy as np

D_MODEL = 2048
BATCH = 2
SEQ = 8192
DEPTH = 1
DEC_BATCH = 16
DEC_SEQ = 16
PAST_LEN = 4096

CHUNK = 64
FOX_HEADS = 8
FOX_HEAD_DIM = 128
FOX_WIDTH = FOX_HEADS * FOX_HEAD_DIM
FOX_SCALE = FOX_HEAD_DIM ** -0.5
Q_BLOCK = 128
FORGET_BIAS_INIT = 3.0
SGU_GROUPS = 8
SGU_CHUNK = 128
SGU_WIDTH = 1024
SGU_GROUP_DIM = SGU_WIDTH // SGU_GROUPS
PEER_HEADS = 8
PEER_N_KEYS = 128
PEER_N_EXPERTS = PEER_N_KEYS * PEER_N_KEYS
PEER_TOPK = 16
PEER_KEY_DIM = 256
PEER_BLOCK = 128
IN_WIDTH = 3 * FOX_WIDTH + FOX_HEADS + 2 * SGU_WIDTH + 2 * D_MODEL
RMS_EPS = 1e-6
NEG_INF = -1e30

kernel_name = 'fox_sgu_peer_stream_step'


def rms_norm(x, g):
    xf = x.astype(jnp.float32)
    y = xf * lax.rsqrt(jnp.mean(xf * xf, axis=-1, keepdims=True) + RMS_EPS)
    return (y * g.astype(jnp.float32)).astype(x.dtype)


def mixer_inputs(h, w_in, b_forget, q_norm_g, k_norm_g, v_norm_g):
    b, s, _ = h.shape
    z = h @ w_in
    o1 = FOX_WIDTH
    o2 = 2 * FOX_WIDTH
    o3 = 3 * FOX_WIDTH
    o4 = o3 + FOX_HEADS
    o5 = o4 + SGU_WIDTH
    o6 = o5 + SGU_WIDTH
    o7 = o6 + D_MODEL
    q, k, v, f, u_s, v_s, gate_a, gate_b = jnp.split(z, [o1, o2, o3, o4, o5, o6, o7], axis=-1)
    q = rms_norm(q.reshape(b, s, FOX_HEADS, FOX_HEAD_DIM), q_norm_g)
    k = rms_norm(k.reshape(b, s, FOX_HEADS, FOX_HEAD_DIM), k_norm_g)
    v = v.reshape(b, s, FOX_HEADS, FOX_HEAD_DIM)
    logf = jax.nn.log_sigmoid((f + b_forget).astype(jnp.float32))
    u_s = jax.nn.gelu(u_s)
    v_s = rms_norm(jax.nn.gelu(v_s), v_norm_g)
    return q, k, v, logf, u_s, v_s, gate_a, gate_b


def fox_block(q, fq, qpos, k, v, fk, kpos):
    logits = jnp.einsum('bqhd,bkhd->bhqk', q, k).astype(jnp.float32) * FOX_SCALE
    decay = jnp.transpose(fq, (0, 2, 1))[..., :, None] - jnp.transpose(fk, (0, 2, 1))[..., None, :]
    mask = kpos[None, :] <= qpos[:, None]
    logits = jnp.where(mask, logits + decay, NEG_INF)
    p = jax.nn.softmax(logits, axis=-1).astype(v.dtype)
    return jnp.einsum('bhqk,bkhd->bqhd', p, v)


def fox_prompt(q, k, v, logf):
    b, s = q.shape[0], q.shape[1]
    nb = s // Q_BLOCK
    fcum = jnp.cumsum(logf, axis=1)
    pos = jnp.arange(s)
    qb = q.reshape(b, nb, Q_BLOCK, FOX_HEADS, FOX_HEAD_DIM).swapaxes(0, 1)
    fb = fcum.reshape(b, nb, Q_BLOCK, FOX_HEADS).swapaxes(0, 1)
    pb = pos.reshape(nb, Q_BLOCK)
    out = lax.map(lambda a: fox_block(a[0], a[1], a[2], k, v, fcum, pos), (qb, fb, pb))
    return out.swapaxes(0, 1).reshape(b, s, FOX_WIDTH)


def fox_sample(q, k, v, logf, cache_k, cache_v, cache_logf):
    b, t = q.shape[0], q.shape[1]
    p = cache_k.shape[1]
    k_all = jnp.concatenate([cache_k.astype(k.dtype), k], axis=1)
    v_all = jnp.concatenate([cache_v.astype(v.dtype), v], axis=1)
    fcum = jnp.cumsum(jnp.concatenate([cache_logf.astype(jnp.float32), logf], axis=1), axis=1)
    kpos = jnp.arange(p + t)
    qpos = p + jnp.arange(t)
    out = fox_block(q, fcum[:, p:], qpos, k_all, v_all, fcum, kpos)
    return out.reshape(b, t, FOX_WIDTH)


def sgu_prompt(u, v, w_s, b_s):
    b, s, _ = u.shape
    nc = s // SGU_CHUNK
    vb = v.reshape(b, nc, SGU_CHUNK, SGU_GROUPS, SGU_GROUP_DIM)
    w = jnp.tril(w_s)
    mixed = jnp.einsum('gij,bnjgc->bnigc', w, vb) + jnp.transpose(b_s)[:, :, None].astype(v.dtype)
    return u * mixed.reshape(b, s, SGU_WIDTH)


def sgu_sample(u, v, w_s, b_s):
    b, t, _ = u.shape
    vb = v.reshape(b, t, SGU_GROUPS, SGU_GROUP_DIM)
    w = jnp.tril(w_s)[:, :t, :t]
    mixed = jnp.einsum('gij,bjgc->bigc', w, vb) + jnp.transpose(b_s[:, :t])[:, :, None].astype(v.dtype)
    return u * mixed.reshape(b, t, SGU_WIDTH)


def merge_branches(o_a, o_b, gate_a, gate_b, w_out_a, w_out_b, w_out):
    y = jax.nn.sigmoid(gate_a) * (o_a @ w_out_a) + jax.nn.sigmoid(gate_b) * (o_b @ w_out_b)
    return y @ w_out


def peer_ffn(xn, w_q, q_norm_g, sub_keys, table_u, table_v):
    b, s, d = xn.shape
    n = b * s
    xf = xn.reshape(n, d)
    pad = (-n) % PEER_BLOCK
    xf = jnp.pad(xf, ((0, pad), (0, 0)))
    blocks = xf.reshape(-1, PEER_BLOCK, d)

    def one_block(xb):
        q = rms_norm((xb @ w_q).reshape(-1, PEER_HEADS, PEER_KEY_DIM), q_norm_g)
        half = PEER_KEY_DIM // 2
        s1 = jnp.einsum('nhd,hkd->nhk', q[..., :half], sub_keys[:, 0]).astype(jnp.float32)
        s2 = jnp.einsum('nhd,hkd->nhk', q[..., half:], sub_keys[:, 1]).astype(jnp.float32)
        t1, i1 = lax.top_k(s1, PEER_TOPK)
        t2, i2 = lax.top_k(s2, PEER_TOPK)
        cand = (t1[..., :, None] + t2[..., None, :]).reshape(-1, PEER_HEADS, PEER_TOPK * PEER_TOPK)
        cidx = (i1[..., :, None] * PEER_N_KEYS + i2[..., None, :]).reshape(-1, PEER_HEADS, PEER_TOPK * PEER_TOPK)
        st, sel = lax.top_k(cand, PEER_TOPK)
        eidx = jnp.take_along_axis(cidx, sel, axis=-1)
        g = jax.nn.softmax(st, axis=-1)
        u_sel = jnp.take(table_u, eidx, axis=0)
        a = jax.nn.gelu(jnp.einsum('nd,nhkd->nhk', xb, u_sel).astype(jnp.float32))
        v_sel = jnp.take(table_v, eidx, axis=0)
        return jnp.einsum('nhk,nhkd->nd', (g * a).astype(xb.dtype), v_sel)

    y = lax.map(one_block, blocks).reshape(-1, d)[:n]
    return y.reshape(b, s, d)


def setup_inputs(seed: int = 0) -> dict:
    key = jax.random.key(seed)
    ks = jax.random.split(key, 22)
    L = DEPTH

    def nrm(k, shape, scale):
        return jax.random.normal(k, shape, jnp.float32) * scale

    return {
        'x_prompt': nrm(ks[0], (BATCH, SEQ, D_MODEL), 1.0),
        'x_sample': nrm(ks[1], (DEC_BATCH, DEC_SEQ, D_MODEL), 1.0),
        'cache_k': nrm(ks[2], (L, DEC_BATCH, PAST_LEN, FOX_HEADS, FOX_HEAD_DIM), 1.0),
        'cache_v': nrm(ks[3], (L, DEC_BATCH, PAST_LEN, FOX_HEADS, FOX_HEAD_DIM), 1.0),
        'cache_logf': jax.nn.log_sigmoid(FORGET_BIAS_INIT + nrm(ks[4], (L, DEC_BATCH, PAST_LEN, FOX_HEADS), 1.0)),
        'norm_mix_g': 1.0 + nrm(ks[5], (L, D_MODEL), 0.02),
        'w_in': nrm(ks[6], (L, D_MODEL, IN_WIDTH), D_MODEL ** -0.5),
        'b_forget': FORGET_BIAS_INIT + nrm(ks[7], (L, FOX_HEADS), 0.5),
        'q_norm_g': 1.0 + nrm(ks[8], (L, FOX_HEAD_DIM), 0.02),
        'k_norm_g': 1.0 + nrm(ks[9], (L, FOX_HEAD_DIM), 0.02),
        'v_norm_g': 1.0 + nrm(ks[10], (L, SGU_WIDTH), 0.02),
        'w_spatial': nrm(ks[11], (L, SGU_GROUPS, SGU_CHUNK, SGU_CHUNK), SGU_CHUNK ** -0.5),
        'b_spatial': 1.0 + nrm(ks[12], (L, SGU_GROUPS, SGU_CHUNK), 0.1),
        'w_out_a': nrm(ks[13], (L, FOX_WIDTH, D_MODEL), FOX_WIDTH ** -0.5),
        'w_out_b': nrm(ks[14], (L, SGU_WIDTH, D_MODEL), SGU_WIDTH ** -0.5),
        'w_out': nrm(ks[15], (L, D_MODEL, D_MODEL), D_MODEL ** -0.5),
        'norm_ffn_g': 1.0 + nrm(ks[16], (L, D_MODEL), 0.02),
        'w_peer_q': nrm(ks[17], (L, D_MODEL, PEER_HEADS * PEER_KEY_DIM), D_MODEL ** -0.5),
        'peer_q_norm_g': 1.0 + nrm(ks[18], (L, PEER_KEY_DIM), 0.02),
        'peer_sub_keys': nrm(ks[19], (L, PEER_HEADS, 2, PEER_N_KEYS, PEER_KEY_DIM // 2), (PEER_KEY_DIM // 2) ** -0.5),
        'peer_u': nrm(ks[20], (L, PEER_N_EXPERTS, D_MODEL), D_MODEL ** -0.5),
        'peer_v': nrm(ks[21], (L, PEER_N_EXPERTS, D_MODEL), 0.1),
    }


def reference(x_prompt, x_sample, cache_k, cache_v, cache_logf, norm_mix_g, w_in, b_forget,
              q_norm_g, k_norm_g, v_norm_g, w_spatial, b_spatial, w_out_a, w_out_b, w_out,
              norm_ffn_g, w_peer_q, peer_q_norm_g, peer_sub_keys, peer_u, peer_v):
    xp = x_prompt
    xs = x_sample
    kp_l, vp_l, fp_l = [], [], []
    ks_l, vs_l, fs_l, us_l = [], [], [], []
    for l in range(DEPTH):
        h = rms_norm(xp, norm_mix_g[l])
        q, k, v, logf, u_s, v_s, ga, gb = mixer_inputs(h, w_in[l], b_forget[l], q_norm_g[l], k_norm_g[l], v_norm_g[l])
        o_a = fox_prompt(q, k, v, logf)
        o_b = sgu_prompt(u_s, v_s, w_spatial[l], b_spatial[l])
        xp = xp + merge_branches(o_a, o_b, ga, gb, w_out_a[l], w_out_b[l], w_out[l])
        xp = xp + peer_ffn(rms_norm(xp, norm_ffn_g[l]), w_peer_q[l], peer_q_norm_g[l], peer_sub_keys[l], peer_u[l], peer_v[l])
        kp_l.append(k)
        vp_l.append(v)
        fp_l.append(logf)

        h = rms_norm(xs, norm_mix_g[l])
        q, k, v, logf, u_s, v_s, ga, gb = mixer_inputs(h, w_in[l], b_forget[l], q_norm_g[l], k_norm_g[l], v_norm_g[l])
        o_a = fox_sample(q, k, v, logf, cache_k[l], cache_v[l], cache_logf[l])
        o_b = sgu_sample(u_s, v_s, w_spatial[l], b_spatial[l])
        xs = xs + merge_branches(o_a, o_b, ga, gb, w_out_a[l], w_out_b[l], w_out[l])
        xs = xs + peer_ffn(rms_norm(xs, norm_ffn_g[l]), w_peer_q[l], peer_q_norm_g[l], peer_sub_keys[l], peer_u[l], peer_v[l])
        ks_l.append(k)
        vs_l.append(v)
        fs_l.append(logf)
        us_l.append(v_s)
    return (xp, xs, jnp.stack(kp_l), jnp.stack(vp_l), jnp.stack(fp_l),
            jnp.stack(ks_l), jnp.stack(vs_l), jnp.stack(fs_l), jnp.stack(us_l))
```

```cpp
#include <hip/hip_runtime.h>
#include <hip/hip_bf16.h>
#include <hip/hip_cooperative_groups.h>
#include <cstdio>
#include <cstdint>
#include <cmath>
#define MK_LAUNCHES 1
namespace pg8 {
#define PG8_LAS __attribute__((address_space(3)))
typedef unsigned short bf16_t;
typedef short bf16x8 __attribute__((ext_vector_type(8)));
typedef float f32x4 __attribute__((ext_vector_type(4)));
typedef unsigned u32x4 __attribute__((ext_vector_type(4)));
constexpr int BM = 256, BK = 64, HALF = 128, HTB = HALF * BK * 2  , STAGE_BYTES = 8 * HTB, NXCD = 8, WGM = 8;

__host__ __device__ __forceinline__ int lds_byte(int r, int c) { const int st = (r >> 4) * 2 + (c >> 5), rr = r & 15, cc = c & 31, ob = rr * 64 + cc * 2; return st * 1024 + (ob ^ (((ob >> 9) & 1) << 5)); }
__host__ __device__ __forceinline__ void stage_rc(int b, int& R, int& C) { const int st = b / 1024, sb = b % 1024, swz = sb ^ (((sb >> 9) & 1) << 5); R = (st >> 1) * 16 + swz / 64; C = (st & 1) * 32 + (swz % 64) / 2; }
__host__ __device__ __forceinline__ int perm32(int rho) { const int n = rho >> 4, i = rho & 15; return 8 * (i >> 2) + 4 * n + (i & 3); }

struct Unit { int pm, pn; };
struct Gemm { const bf16_t* A; const bf16_t* Bt; int M, N, K; };

struct StaticOrder {
    int nM, nN, nwg, G, c;
    __host__ __device__ void init(int M, int N, int G_, int c_) { nM = M / BM; nN = N / BM; nwg = nM * nN; G = G_; c = c_; }
    __host__ __device__ bool next(int i, Unit& u) const {
        const long L = (long)i * G + c; if (L >= nwg) return false;
        int wgid = (int)L; { const int q = nwg / NXCD, r = nwg % NXCD, xcd = wgid % NXCD, off = wgid / NXCD; wgid = (xcd < r ? xcd * (q + 1) : r * (q + 1) + (xcd - r) * q) + off; }
        const int nig = WGM * nN, gid = wgid / nig, fm = gid * WGM, gsz = (nM - fm) < WGM ? (nM - fm) : WGM;
        u.pm = fm + ((wgid % nig) % gsz); u.pn = (wgid % nig) / gsz; return true;
    }
    __device__ __forceinline__ void a_ready(const Unit&) const {}
    __device__ __forceinline__ void done(const Unit&) const {}
};

__device__ __forceinline__ unsigned cvt_pk_bf16(float lo, float hi) { unsigned r; asm volatile("v_cvt_pk_bf16_f32 %0, %1, %2" : "=v"(r) : "v"(lo), "v"(hi)); return r; }
typedef float f32x2 __attribute__((ext_vector_type(2)));
template <class Epi, class Sched, bool ALIGN_EPI = false, bool SP2 = false>
__device__ __forceinline__ void gemm_phase(PG8_LAS unsigned char* lds, const Gemm g, const Sched& S, const Epi& E) {
    const int tid = threadIdx.x, wid = __builtin_amdgcn_readfirstlane(tid >> 6), lane = tid & 63, wr = wid >> 2, wc = wid & 3, fr = lane & 15, fq = lane >> 4;
    const int K = g.K, nt = K / BK;
    unsigned voffA[2], voffB[2];
#pragma unroll
    for (int i = 0; i < 2; ++i) { int R, C; stage_rc(tid * 16 + i * 8192, R, C); const int Rb = Epi::PERM ? ((R & ~31) + perm32(R & 31)) : R;
        voffA[i] = (unsigned)(R * K + C) * 2u; voffB[i] = (unsigned)(Rb * K + C) * 2u; }
    const size_t kstep = (size_t)(BK * 2);
    const size_t hstep = (size_t)HALF * K * 2;
    const size_t tstep = 2 * hstep;
    const unsigned ldsw = (unsigned)wid * 1024u;
    const int aoff = lds_byte(wr * 64 + fr, fq * 8), boff = lds_byte(wc * 32 + fr, fq * 8);
#define PG8_SA(b, h) (((b) * 2 + (h)) * HTB)
#define PG8_SB(b, h) ((4 + (b) * 2 + (h)) * HTB)
#define PG8_STAGE(bufoff, gbase, voff) do { _Pragma("unroll") for (int _i = 0; _i < 2; ++_i) \
        __builtin_amdgcn_global_load_lds((const unsigned*)((const char*)(gbase) + (voff)[_i]), (PG8_LAS unsigned*)(lds + (bufoff) + ldsw + _i * 8192), 16, 0, 0); } while (0)
#define PG8_LDA(dst, b, h) do { _Pragma("unroll") for (int m = 0; m < 4; ++m) _Pragma("unroll") for (int k = 0; k < 2; ++k) dst[m][k] = *(const PG8_LAS bf16x8*)(lds + PG8_SA(b, h) + aoff + m * 2048 + k * 1024); } while (0)
#define PG8_LDB(dst, b, h) do { _Pragma("unroll") for (int n = 0; n < 2; ++n) _Pragma("unroll") for (int k = 0; k < 2; ++k) dst[n][k] = *(const PG8_LAS bf16x8*)(lds + PG8_SB(b, h) + boff + n * 2048 + k * 1024); } while (0)
#define PG8_MMA(ai, bj, At, Bt) do { __builtin_amdgcn_s_setprio(1); _Pragma("unroll") for (int m = 0; m < 4; ++m) _Pragma("unroll") for (int n = 0; n < 2; ++n) _Pragma("unroll") for (int k = 0; k < 2; ++k) \
        acc[ai][bj][m][n] = __builtin_amdgcn_mfma_f32_16x16x32_bf16(Bt[n][k], At[m][k], acc[ai][bj][m][n], 0, 0, 0); __builtin_amdgcn_s_setprio(0); } while (0)
#define PG8_WAIT_V(n) asm volatile("s_waitcnt vmcnt(" #n ")" ::: "memory")
#define PG8_WAIT_L(n) asm volatile("s_waitcnt lgkmcnt(" #n ")" ::: "memory")
#define PG8_BAR __builtin_amdgcn_s_barrier()
#define PG8_SCHED __builtin_amdgcn_sched_barrier(0)
    Unit cur, nxt; int ui = 0;
    if (!S.next(0, cur)) return;
    f32x4 acc[2][2][4][2];
#pragma unroll
    for (int a = 0; a < 2; ++a)
#pragma unroll
        for (int b = 0; b < 2; ++b)
#pragma unroll
            for (int m = 0; m < 4; ++m)
#pragma unroll
                for (int n = 0; n < 2; ++n) acc[a][b][m][n] = (f32x4){0.f, 0.f, 0.f, 0.f};
    bf16x8 At[4][2], B0[2][2], B1[2][2];
    const char* cA = (const char*)g.A + (size_t)cur.pm * tstep; const char* cB = (const char*)g.Bt + (size_t)cur.pn * tstep;
    S.a_ready(cur);
    if constexpr (SP2) {
        PG8_STAGE(PG8_SB(0, 0), cB, voffB); PG8_STAGE(PG8_SB(0, 1), cB + hstep, voffB); PG8_STAGE(PG8_SA(0, 0), cA, voffA); PG8_STAGE(PG8_SA(0, 1), cA + hstep, voffA);
        if (wr == 1) PG8_BAR;
        PG8_WAIT_V(2); PG8_BAR;
        PG8_STAGE(PG8_SB(1, 0), cB + kstep, voffB); PG8_STAGE(PG8_SA(1, 0), cA + kstep, voffA); PG8_STAGE(PG8_SB(1, 1), cB + hstep + kstep, voffB);
        PG8_WAIT_V(6); PG8_BAR;
    } else {
        PG8_STAGE(PG8_SB(0, 0), cB, voffB); PG8_STAGE(PG8_SA(0, 0), cA, voffA); PG8_STAGE(PG8_SB(0, 1), cB + hstep, voffB); PG8_STAGE(PG8_SA(0, 1), cA + hstep, voffA);
        if (wr == 1) PG8_BAR;
        PG8_WAIT_V(4); PG8_BAR;
        PG8_STAGE(PG8_SB(1, 0), cB + kstep, voffB); PG8_STAGE(PG8_SA(1, 0), cA + kstep, voffA); PG8_STAGE(PG8_SB(1, 1), cB + hstep + kstep, voffB);
        PG8_WAIT_V(6); PG8_BAR;
    }
    for (;;) {
        const bool has_next = S.next(ui + 1, nxt);
        const char* nA = has_next ? (const char*)g.A + (size_t)nxt.pm * tstep : cA; const char* nB = has_next ? (const char*)g.Bt + (size_t)nxt.pn * tstep : cB;
        for (int t = 0; t < nt; t += 2) {
            const bool last = (t == nt - 2);
            const char* a1 = cA + (size_t)(t + 1) * kstep;
            const char* a2 = last ? nA : cA + (size_t)(t + 2) * kstep; const char* b2 = last ? nB : cB + (size_t)(t + 2) * kstep;
            const char* a3 = a2 + kstep; const char* b3 = b2 + kstep;
            if (last && has_next) S.a_ready(nxt);
            if constexpr (SP2) {
            PG8_LDB(B0, 0, 0); PG8_LDB(B1, 0, 1); PG8_SCHED; PG8_LDA(At, 0, 0); PG8_STAGE(PG8_SA(1, 1), a1 + hstep, voffA);
            PG8_WAIT_V(8); PG8_WAIT_L(0); PG8_BAR; PG8_MMA(0, 0, At, B0); PG8_MMA(0, 1, At, B1); PG8_BAR; PG8_SCHED;
            PG8_LDA(At, 0, 1); PG8_STAGE(PG8_SB(0, 0), b2, voffB); PG8_STAGE(PG8_SB(0, 1), b2 + hstep, voffB); PG8_STAGE(PG8_SA(0, 0), a2, voffA);
            PG8_WAIT_V(8); PG8_WAIT_L(0); PG8_BAR; PG8_MMA(1, 0, At, B0); PG8_MMA(1, 1, At, B1); PG8_BAR; PG8_SCHED;
            PG8_LDB(B0, 1, 0); PG8_LDB(B1, 1, 1); PG8_SCHED; PG8_LDA(At, 1, 0); PG8_STAGE(PG8_SA(0, 1), a2 + hstep, voffA);
            PG8_WAIT_V(8); PG8_WAIT_L(0); PG8_BAR; PG8_MMA(0, 0, At, B0); PG8_MMA(0, 1, At, B1); PG8_BAR; PG8_SCHED;
            PG8_LDA(At, 1, 1); PG8_STAGE(PG8_SB(1, 0), b3, voffB); PG8_STAGE(PG8_SB(1, 1), b3 + hstep, voffB); PG8_STAGE(PG8_SA(1, 0), a3, voffA);
            PG8_WAIT_V(8); PG8_WAIT_L(0); PG8_BAR; PG8_MMA(1, 0, At, B0); PG8_MMA(1, 1, At, B1); PG8_BAR; PG8_SCHED;
            } else {
            PG8_LDB(B0, 0, 0); PG8_SCHED; PG8_LDA(At, 0, 0); PG8_STAGE(PG8_SA(1, 1), a1 + hstep, voffA);
            PG8_WAIT_L(8); PG8_BAR; PG8_WAIT_L(0); PG8_MMA(0, 0, At, B0); PG8_BAR; PG8_SCHED;
            PG8_LDB(B1, 0, 1); PG8_STAGE(PG8_SB(0, 0), b2, voffB);
            PG8_BAR; PG8_WAIT_L(0); PG8_MMA(0, 1, At, B1); PG8_BAR;
            PG8_LDA(At, 0, 1); PG8_STAGE(PG8_SA(0, 0), a2, voffA);
            PG8_BAR; PG8_WAIT_L(0); PG8_MMA(1, 0, At, B0); PG8_BAR; PG8_SCHED;
            PG8_STAGE(PG8_SB(0, 1), b2 + hstep, voffB);
            PG8_WAIT_V(6); PG8_BAR; PG8_MMA(1, 1, At, B1); PG8_BAR;
            PG8_LDB(B0, 1, 0); PG8_SCHED; PG8_LDA(At, 1, 0); PG8_STAGE(PG8_SA(0, 1), a2 + hstep, voffA);
            PG8_WAIT_L(8); PG8_BAR; PG8_WAIT_L(0); PG8_MMA(0, 0, At, B0); PG8_BAR; PG8_SCHED;
            PG8_LDB(B1, 1, 1); PG8_STAGE(PG8_SB(1, 0), b3, voffB);
            PG8_BAR; PG8_WAIT_L(0); PG8_MMA(0, 1, At, B1); PG8_BAR;
            PG8_LDA(At, 1, 1); PG8_STAGE(PG8_SA(1, 0), a3, voffA);
            PG8_BAR; PG8_WAIT_L(0); PG8_MMA(1, 0, At, B0); PG8_BAR; PG8_SCHED;
            PG8_STAGE(PG8_SB(1, 1), b3 + hstep, voffB);
            PG8_WAIT_V(6); PG8_BAR; PG8_MMA(1, 1, At, B1); PG8_BAR;
            }
        }
        if constexpr (ALIGN_EPI) { if (wr == 0) PG8_BAR; }
        if constexpr (!Epi::AFTER_DRAIN) { E(acc, cur, wr, wc, fr, fq); S.done(cur); }
        if (!has_next) break;
#pragma unroll
        for (int a = 0; a < 2; ++a)
#pragma unroll
            for (int b = 0; b < 2; ++b)
#pragma unroll
                for (int m = 0; m < 4; ++m)
#pragma unroll
                    for (int n = 0; n < 2; ++n) acc[a][b][m][n] = (f32x4){0.f, 0.f, 0.f, 0.f};
        cur = nxt; cA = nA; cB = nB; ++ui;
        if constexpr (ALIGN_EPI) { if (wr == 1) PG8_BAR; }
    }
    PG8_WAIT_V(0);
    if constexpr (!ALIGN_EPI) { if (wr == 0) PG8_BAR; }
    PG8_BAR;
    if constexpr (Epi::AFTER_DRAIN) { E.fused(acc, cur, wr, wc, fr, fq, lds, wid, lane); S.done(cur); }
#undef PG8_SA
#undef PG8_SB
#undef PG8_STAGE
#undef PG8_LDA
#undef PG8_LDB
#undef PG8_MMA
#undef PG8_WAIT_V
#undef PG8_WAIT_L
#undef PG8_BAR
#undef PG8_SCHED
}
}
namespace attn {
constexpr int D = 128, NW = 8, QBLK = 32, KVBLK = 64, QB = NW * QBLK;
constexpr int SHM_V = KVBLK * D * 2, SHM_K = KVBLK * D * 2;
constexpr int LDS_BYTES = 2 * SHM_V + 2 * SHM_K + NW * 64 * 4;
constexpr float SCALE = 0.08838834764831845f;
#ifndef OSTR_V
#define OSTR_V 1024
#endif
constexpr float THR = 20.f;
constexpr bool WSKIP = false;
constexpr bool NO_SEAM_PREFETCH = true;
constexpr int OSTR = OSTR_V;
using bf16 = __hip_bfloat16;
typedef short bf16x8 __attribute__((ext_vector_type(8)));
typedef short s16x4 __attribute__((ext_vector_type(4)));
typedef float f32x16 __attribute__((ext_vector_type(16)));
typedef float f32x4 __attribute__((ext_vector_type(4)));
typedef unsigned u32x4 __attribute__((ext_vector_type(4)));
template <class A, class Bt> struct same_t { static constexpr bool v = false; };
template <class A> struct same_t<A, A> { static constexpr bool v = true; };

#define KSWZ(row, colB) ((row) * 256 + ((colB) ^ (((row) & 7) << 4)))
#define SBAR() __builtin_amdgcn_sched_barrier(0)
__device__ __forceinline__ int v_st(int k, int c) { const int kk = (k & ~0xC) | ((k & 4) << 1) | ((k & 8) >> 1); return ((kk >> 3) * 4 + (c >> 5)) * 512 + ((kk & 7) * 32 + (c & 31)) * 2; }
__device__ __forceinline__ int v_rd_base(int lane) { return ((lane & 3) << 3) | (((lane >> 2) & 3) << 6) | (((lane >> 4) & 1) << 5) | (((lane >> 5) & 1) << 8); }
constexpr int v_rd_off(int d0, int ks, int half) { return d0 * 512 + ks * 4096 + half * 2048; }
__device__ __forceinline__ int crow(int r, int hi) { return (r & 3) + 8 * (r >> 2) + 4 * hi; }
__device__ __forceinline__ unsigned cvtpk(float lo, float hi) {
    unsigned r; asm volatile("v_cvt_pk_bf16_f32 %0, %1, %2" : "=v"(r) : "v"(lo), "v"(hi)); return r;
}
__device__ __forceinline__ bf16x8 pack8(f32x4 a, f32x4 b) {
    u32x4 w = {cvtpk(a[0], a[1]), cvtpk(a[2], a[3]), cvtpk(b[0], b[1]), cvtpk(b[2], b[3])};
    return *reinterpret_cast<bf16x8*>(&w);
}
template <class T> __device__ __forceinline__ bf16x8 load8(const T* p) {
    if constexpr (same_t<T, float>::v) { return pack8(*(const f32x4*)p, *(const f32x4*)(p + 4)); }
    else { return *reinterpret_cast<const bf16x8*>(p); }
}
__device__ __forceinline__ void mask_tile(f32x16& p0, f32x16& p1, int dq, unsigned W) {
    const float NEG = -__builtin_inff();
#pragma unroll
    for (int r = 0; r < 16; ++r) {
        const int c = (r & 3) + 8 * (r >> 2);
        if ((unsigned)(dq - c) >= W) p0[r] = NEG;
        if ((unsigned)(dq - c - 32) >= W) p1[r] = NEG;
    }
}
__device__ __forceinline__ void partialSM(f32x16& p0, f32x16& p1, float& m_reg, float& mn, float& alpha) {
    float pmax = p0[0]; for (int r = 1; r < 16; ++r) pmax = fmaxf(pmax, p0[r]); for (int r = 0; r < 16; ++r) pmax = fmaxf(pmax, p1[r]);
    { auto rr = __builtin_amdgcn_permlane32_swap(__float_as_uint(pmax), __float_as_uint(pmax), false, false);
      pmax = fmaxf(__uint_as_float(rr[0]), __uint_as_float(rr[1])); }
    constexpr float C2 = 1.4426950408889634f * SCALE;
    if (__builtin_expect(__all((pmax - m_reg) * SCALE <= THR), 1)) { mn = m_reg; alpha = 1.f; }
    else { mn = fmaxf(m_reg, pmax); alpha = __builtin_amdgcn_exp2f((m_reg - mn) * C2); m_reg = mn; }
    const float mnL = -mn * C2;
    for (int r = 0; r < 16; ++r) p0[r] = fmaf(p0[r], C2, mnL); for (int r = 0; r < 16; ++r) p1[r] = fmaf(p1[r], C2, mnL);
    for (int r = 0; r < 16; ++r) p0[r] = __builtin_amdgcn_exp2f(p0[r]);
}
__device__ __forceinline__ void finishSM(f32x16& p0, f32x16& p1, float alpha, float& l_reg, bf16x8& pa0, bf16x8& pa1, bf16x8& pa2, bf16x8& pa3) {
    for (int r = 0; r < 16; ++r) p1[r] = __builtin_amdgcn_exp2f(p1[r]);
    float ps = 0; for (int r = 0; r < 16; ++r) ps += p0[r]; for (int r = 0; r < 16; ++r) ps += p1[r];
    { auto rr = __builtin_amdgcn_permlane32_swap(__float_as_uint(ps), __float_as_uint(ps), false, false);
      ps = __uint_as_float(rr[0]) + __uint_as_float(rr[1]); }
    l_reg = l_reg * alpha + ps;
#define PK4(P, B_, OUT) do { unsigned a0 = cvtpk(P[B_+0], P[B_+1]), a1 = cvtpk(P[B_+2], P[B_+3]);                          \
        unsigned b0 = cvtpk(P[B_+4], P[B_+5]), b1 = cvtpk(P[B_+6], P[B_+7]);                                             \
        auto r0 = __builtin_amdgcn_permlane32_swap(a0, b0, false, false); auto r1 = __builtin_amdgcn_permlane32_swap(a1, b1, false, false); \
        u32x4 w = {r0[0], r1[0], r0[1], r1[1]}; OUT = *reinterpret_cast<bf16x8*>(&w); } while (0)
    PK4(p0, 0, pa0); PK4(p0, 8, pa1); PK4(p1, 0, pa2); PK4(p1, 8, pa3);
#undef PK4
}
template <int KB, bool SK>
__device__ __forceinline__ void qkt(f32x16& p0, f32x16& p1, const char* K_lds, int r32, int hi, const bf16x8* qr, bool act, const float* bt) {
    if (SK && !act) { const float NEG = -__builtin_inff();
#pragma unroll
        for (int r = 0; r < 16; ++r) { p0[r] = NEG; p1[r] = NEG; } return; }
#ifdef NO_BIAS
    p0 = f32x16{}; p1 = f32x16{};
#else
    {
#pragma unroll
        for (int j = 0; j < 4; ++j) { const f32x4 a = *(const f32x4*)(bt + 8 * j), b = *(const f32x4*)(bt + 32 + 8 * j);
            p0[4 * j] = a[0]; p0[4 * j + 1] = a[1]; p0[4 * j + 2] = a[2]; p0[4 * j + 3] = a[3]; p1[4 * j] = b[0]; p1[4 * j + 1] = b[1]; p1[4 * j + 2] = b[2]; p1[4 * j + 3] = b[3]; } }
#endif
    const char* kb[4];
#pragma unroll
    for (int dd = 0; dd < 4; ++dd) kb[dd] = K_lds + KB * SHM_K + KSWZ(r32, (dd * 16 + hi * 8) * 2);
#pragma unroll
    for (int d0 = 0; d0 < 8; ++d0) { const char* a = kb[d0 & 3] + (d0 >> 2) * 128;
        bf16x8 b0 = *reinterpret_cast<const bf16x8*>(a);
        bf16x8 b1 = *reinterpret_cast<const bf16x8*>(a + 32 * 256);
        p0 = __builtin_amdgcn_mfma_f32_32x32x16_bf16(b0, qr[d0], p0, 0, 0, 0);
        p1 = __builtin_amdgcn_mfma_f32_32x32x16_bf16(b1, qr[d0], p1, 0, 0, 0); }
}
template <int VB, bool SK>
__device__ __forceinline__ void pv_tile(f32x16* o, int vb0, bf16x8 pa0, bf16x8 pa1, bf16x8 pa2, bf16x8 pa3, bool act) {
    if (SK && !act) return;
#define TRRD(dst, off) asm volatile("ds_read_b64_tr_b16 %0, %1 offset:%2" : "=&v"(dst) : "v"(vb0), "i"(off) : "memory")
#define PV_D0(d0) do { s16x4 l0, l1, l2, l3, h0, h1, h2, h3; constexpr int b_ = VB * SHM_V + v_rd_off(d0, 0, 0);     \
        TRRD(l0, b_); TRRD(h0, b_ + 2048); TRRD(l1, b_ + 4096); TRRD(h1, b_ + 6144); TRRD(l2, b_ + 8192); TRRD(h2, b_ + 10240); TRRD(l3, b_ + 12288); TRRD(h3, b_ + 14336); \
        asm volatile("s_waitcnt lgkmcnt(0)" ::: "memory"); SBAR();                 \
        o[d0] = __builtin_amdgcn_mfma_f32_32x32x16_bf16(pa0, (bf16x8){l0[0], l0[1], l0[2], l0[3], h0[0], h0[1], h0[2], h0[3]}, o[d0], 0, 0, 0);   \
        o[d0] = __builtin_amdgcn_mfma_f32_32x32x16_bf16(pa1, (bf16x8){l1[0], l1[1], l1[2], l1[3], h1[0], h1[1], h1[2], h1[3]}, o[d0], 0, 0, 0);   \
        o[d0] = __builtin_amdgcn_mfma_f32_32x32x16_bf16(pa2, (bf16x8){l2[0], l2[1], l2[2], l2[3], h2[0], h2[1], h2[2], h2[3]}, o[d0], 0, 0, 0);   \
        o[d0] = __builtin_amdgcn_mfma_f32_32x32x16_bf16(pa3, (bf16x8){l3[0], l3[1], l3[2], l3[3], h3[0], h3[1], h3[2], h3[3]}, o[d0], 0, 0, 0); } while (0)
    PV_D0(0); PV_D0(1); PV_D0(2); PV_D0(3);
#undef PV_D0
#undef TRRD
}

template <class TIn, class TOut> struct BlockRef { const TIn* Q; const TIn* K; const TIn* V; TOut* O; int P0; int jlo; };
template <class TIn> struct Seam {
    bf16x8 qr[8];
    bf16x8 st_v0, st_v1, st_k0, st_k1; f32x4 sf0, sf1, sf2, sf3;
    f32x4 tq[16];
};
__device__ __forceinline__ int swa_jlo(int P0, int W) { const int lowk = P0 - W + 1; return lowk > 0 ? lowk / KVBLK : 0; }
#define ROW(p, k0, rr) ((p) + (size_t)((k0) + (rr)) * D + sc)
#define VMW() asm volatile("s_waitcnt vmcnt(0)" ::: "memory")
#define VMWN(n) asm volatile("s_waitcnt vmcnt(%0)" :: "i"(n) : "memory")
#define SLOAD_H(Kp, Vp, k0) do { S.st_v0 = load8<TIn>(ROW(Vp, k0, sr)); S.st_v1 = load8<TIn>(ROW(Vp, k0, 32 + sr));              \
                         S.st_k0 = load8<TIn>(ROW(Kp, k0, sr)); S.st_k1 = load8<TIn>(ROW(Kp, k0, 32 + sr)); } while (0)
#define SWRITE_HK(bf) do { *(bf16x8*)(K_lds + (bf) * SHM_K + kws) = S.st_k0; *(bf16x8*)(K_lds + (bf) * SHM_K + kws + 32 * 256) = S.st_k1; } while (0)
#define SWRITE_HV(bf) do { *(bf16x8*)(V_lds + (bf) * SHM_V + vst0) = S.st_v0; *(bf16x8*)(V_lds + (bf) * SHM_V + vst1) = S.st_v1; } while (0)
#define SWRITE_H(bf) do { SWRITE_HV(bf); SWRITE_HK(bf); } while (0)
#define SLOAD_F(p, k0) do { S.sf0 = *(const f32x4*)ROW(p, k0, sr); S.sf1 = *(const f32x4*)(ROW(p, k0, sr) + 4);                \
                            S.sf2 = *(const f32x4*)ROW(p, k0, 32 + sr); S.sf3 = *(const f32x4*)(ROW(p, k0, 32 + sr) + 4); } while (0)
#define SWRITE_KF(bf) do { *(bf16x8*)(K_lds + (bf) * SHM_K + kws) = pack8(S.sf0, S.sf1); *(bf16x8*)(K_lds + (bf) * SHM_K + kws + 32 * 256) = pack8(S.sf2, S.sf3); } while (0)
#define SWRITE_VF(bf) do { *(bf16x8*)(V_lds + (bf) * SHM_V + vst0) = pack8(S.sf0, S.sf1); *(bf16x8*)(V_lds + (bf) * SHM_V + vst1) = pack8(S.sf2, S.sf3); } while (0)
template <class TIn, class TOut>
__device__ __forceinline__ void causal_swa_prime(const BlockRef<TIn, TOut>& cur, int W, char* lds, Seam<TIn>& S) {
    constexpr bool F32 = same_t<TIn, float>::v;
    int tid_o = threadIdx.x;
#ifndef NO_OPAQ
    asm volatile("" : "+v"(tid_o));
#endif
    const int tid = tid_o, wid = __builtin_amdgcn_readfirstlane(tid >> 6), lane = tid & 63, r32 = lane & 31, hi = lane >> 5;
    const int sr = tid >> 4, sc = (tid & 15) * 8, kws = KSWZ(sr, sc * 2); char* K_lds = lds + 2 * SHM_V;
    const int kb0 = cur.jlo * KVBLK;
    for (int d0 = 0; d0 < 8; ++d0) S.qr[d0] = load8<TIn>(cur.Q + (size_t)(wid * QBLK + r32) * D + d0 * 16 + hi * 8);
    if constexpr (F32) { SLOAD_F((const float*)cur.K, kb0); VMW(); SWRITE_KF(0); SBAR(); SLOAD_F((const float*)cur.V, kb0); }
    else { SLOAD_H(cur.K, cur.V, kb0); VMW(); SWRITE_HK(0); }
    __syncthreads();
}
template <class TIn, class TOut>
__device__ __forceinline__ void causal_swa_block(const BlockRef<TIn, TOut>& cur, const BlockRef<TIn, TOut>& nxt, int skv, int W, char* lds, Seam<TIn>& S, const float* bias_lds) {
    constexpr bool F32 = same_t<TIn, float>::v;
    int tid_o = threadIdx.x;
#ifndef NO_OPAQ
    asm volatile("" : "+v"(tid_o));
#endif
    const int tid = tid_o, wid = __builtin_amdgcn_readfirstlane(tid >> 6), lane = tid & 63, r32 = lane & 31, hi = lane >> 5;
    const int j_lo = cur.jlo;
    int j_hi = (cur.P0 + QB - 1) / KVBLK + 1; if (j_hi > skv / KVBLK) j_hi = skv / KVBLK;
    const int NT = j_hi - j_lo;
    const int kbn = nxt.jlo * KVBLK;
    const int qlo = cur.P0 + wid * QBLK, qm = qlo + r32 - 4 * hi;
    char* V_lds = lds; char* K_lds = lds + 2 * SHM_V;
    float* ws = (float*)(lds + 2 * SHM_V + 2 * SHM_K) + wid * 64; float* li_l = ws, * al_l = ws + 32;
    float m_reg = -1e30f, l_reg = 0; f32x16 o[4] = {};
    const int sr = tid >> 4, sc = (tid & 15) * 8, vst0 = v_st(sr, sc), vst1 = v_st(32 + sr, sc), kws = KSWZ(sr, sc * 2);
    const int vb0 = (int)(uintptr_t)V_lds + v_rd_base(lane);
    const TIn* Kh = cur.K; const TIn* Vh = cur.V;
#define RESC(a) do { if (__any((a) < 1.f)) { if (hi == 0) al_l[r32] = (a); asm volatile("s_waitcnt lgkmcnt(0)" ::: "memory");              \
                     for (int d_ = 0; d_ < 4; ++d_) for (int r = 0; r < 16; ++r) o[d_][r] *= al_l[crow(r, hi)]; } } while (0)
#define KBASE(t) ((j_lo + (t)) * KVBLK)
#define BT(t) (bias_lds + KBASE(t) + 4 * hi)
#define ACT(t) (KBASE(t) <= qlo + QBLK - 1 && KBASE(t) + KVBLK - 1 >= qlo - W + 1)
#define MASKT(P0_, P1_, t) do { const int kb_ = KBASE(t); if ((!SK || ACT(t)) && (kb_ + KVBLK - 1 > qlo || kb_ <= qlo + QBLK - 1 - W)) mask_tile(P0_, P1_, qm - kb_, (unsigned)W); } while (0)
    constexpr int NQL = F32 ? 16 : 8;
    constexpr bool SK = WSKIP && !F32;
#define SEAM_K0() do { VMWN(NQL); if constexpr (F32) { SWRITE_KF(0); SBAR(); SLOAD_F((const float*)nxt.V, kbn); } else { SWRITE_HK(0); } SBAR(); } while (0)
    f32x16 pA0, pA1, pB0, pB1; float mnA, mnB, alA, alB; bf16x8 pa0, pa1, pa2, pa3;
    if constexpr (F32) { VMW(); SWRITE_VF(0); SBAR(); } else { SWRITE_HV(0); SBAR(); }
    if (NT > 1) { if constexpr (F32) SLOAD_F((const float*)Kh, KBASE(1)); else SLOAD_H(Kh, Vh, KBASE(1)); }
    SBAR(); qkt<0, SK>(pA0, pA1, K_lds, r32, hi, S.qr, ACT(0), BT(0));
    if constexpr (F32) { if (NT > 1) { VMW(); SWRITE_KF(1); SBAR(); SLOAD_F((const float*)Vh, KBASE(1)); } }
    MASKT(pA0, pA1, 0); partialSM(pA0, pA1, m_reg, mnA, alA);
    if (NT > 1) { VMW(); if constexpr (F32) { SWRITE_VF(1); SBAR(); if (NT > 2) SLOAD_F((const float*)Kh, KBASE(2)); } else SWRITE_H(1); }
    __syncthreads();
#define HALF_STEP(PX0, PX1, mnX, alX, PY0, PY1, alY, t, KB, VB, SB) do {                                                      \
        SBAR(); qkt<KB, SK>(PX0, PX1, K_lds, r32, hi, S.qr, ACT(t), BT(t));                                             \
        finishSM(PY0, PY1, alY, l_reg, pa0, pa1, pa2, pa3); SBAR();                                                           \
        if ((t) + 1 < NT) { if constexpr (F32) { VMW(); SWRITE_KF(SB); SBAR(); SLOAD_F((const float*)Vh, KBASE((t) + 1)); }  \
                            else { SLOAD_H(Kh, Vh, KBASE((t) + 1)); } SBAR(); }                                               \
        pv_tile<VB, SK>(o, vb0, pa0, pa1, pa2, pa3, ACT((t) - 1)); MASKT(PX0, PX1, (t)); partialSM(PX0, PX1, m_reg, mnX, alX);                                        \
        __syncthreads();                                                                                                      \
        if ((t) + 1 < NT) { VMW(); if constexpr (F32) { SWRITE_VF(SB); SBAR(); if ((t) + 2 < NT) SLOAD_F((const float*)Kh, KBASE((t) + 2)); } \
                            else { SWRITE_H(SB); } }                                                                          \
        RESC(alX); __syncthreads(); } while (0)
    for (int t = 1; t + 1 < NT; t += 2) {
        HALF_STEP(pB0, pB1, mnB, alB, pA0, pA1, alA, t, 1, 0, 0);
        HALF_STEP(pA0, pA1, mnA, alA, pB0, pB1, alB, t + 1, 0, 1, 1);
    }
    const bool even = (NT & 1) == 0;
    if (even) { SBAR(); qkt<1, SK>(pB0, pB1, K_lds, r32, hi, S.qr, ACT(NT - 1), BT(NT - 1)); SBAR(); }
#define QROW(e) (nxt.Q + (size_t)(wid * QBLK + r32) * D + ((e) >> 1) * 16 + hi * 8 + ((e) & 1) * 4)
    if constexpr (F32) { SLOAD_F((const float*)nxt.K, kbn); SBAR();
#pragma unroll
        for (int e = 0; e < 8; ++e) S.tq[e] = *(const f32x4*)QROW(e); }
    else if (!NO_SEAM_PREFETCH) { SLOAD_H(nxt.K, nxt.V, kbn); SBAR();
#pragma unroll
        for (int d0 = 0; d0 < 8; ++d0) S.qr[d0] = load8<TIn>(nxt.Q + (size_t)(wid * QBLK + r32) * D + d0 * 16 + hi * 8); }
    SBAR();
    finishSM(pA0, pA1, alA, l_reg, pa0, pa1, pa2, pa3); SBAR();
    if constexpr (F32) {
#pragma unroll
        for (int e = 8; e < 16; ++e) S.tq[e] = *(const f32x4*)QROW(e); SBAR(); }
#undef QROW
    pv_tile<0, SK>(o, vb0, pa0, pa1, pa2, pa3, ACT(even ? NT - 2 : NT - 1));
    if (even) { MASKT(pB0, pB1, NT - 1); partialSM(pB0, pB1, m_reg, mnB, alB); __syncthreads(); RESC(alB);
        finishSM(pB0, pB1, alB, l_reg, pa0, pa1, pa2, pa3); SBAR(); pv_tile<1, SK>(o, vb0, pa0, pa1, pa2, pa3, ACT(NT - 1)); }
    SBAR(); if (!NO_SEAM_PREFETCH) SEAM_K0();
    if (hi == 0) li_l[r32] = l_reg; asm volatile("s_waitcnt lgkmcnt(0)" ::: "memory");
    float rli[16];
#pragma unroll
    for (int r = 0; r < 16; ++r) rli[r] = __builtin_amdgcn_rcpf(li_l[crow(r, hi)]);
    TOut* Ow = cur.O + (size_t)(wid * QBLK) * OSTR;
#pragma unroll
    for (int r = 0; r < 16; ++r) { const int orow = crow(r, hi);
#pragma unroll
        for (int d0 = 0; d0 < 4; ++d0) { const float v = o[d0][r] * rli[r];
            if constexpr (same_t<TOut, float>::v) { Ow[(size_t)orow * OSTR + d0 * 32 + r32] = v; }
            else { const float vn = __shfl_xor(v, 1);
                   if ((r32 & 1) == 0) *(unsigned*)(Ow + (size_t)orow * OSTR + d0 * 32 + r32) = cvtpk(v, vn); } } }
    if constexpr (F32) {
#pragma unroll
        for (int d0 = 0; d0 < 8; ++d0) S.qr[d0] = pack8(S.tq[2 * d0], S.tq[2 * d0 + 1]); }
    __syncthreads();
#undef RESC
#undef KBASE
#undef BT
#undef ACT
#undef MASKT
#undef SEAM_K0
#undef HALF_STEP
}
#undef ROW
#undef VMW
#undef VMWN
#undef SLOAD_H
#undef SWRITE_HK
#undef SWRITE_HV
#undef SWRITE_H
#undef SLOAD_F
#undef SWRITE_KF
#undef SWRITE_VF
#undef KSWZ
#undef SBAR
}
#define GAS __attribute__((address_space(1)))
#define LAS __attribute__((address_space(3)))
typedef unsigned short hbf;
typedef unsigned v4u __attribute__((ext_vector_type(4)));
typedef unsigned v2u __attribute__((ext_vector_type(2)));
typedef float f32x4 __attribute__((ext_vector_type(4)));
typedef float f32x16 __attribute__((ext_vector_type(16)));
typedef short bf16x8 __attribute__((ext_vector_type(8)));
typedef __bf16 bf16x2_t __attribute__((ext_vector_type(2)));

constexpr int DM = 2048, NBATCH = 2, SEQ = 8192, DBATCH = 16, DSEQ = 16, PAST = 4096;
constexpr int MP = NBATCH * SEQ, MS = DBATCH * DSEQ, MT = MP + MS;
constexpr int FH = 8, FD = 128, FW = FH * FD, SGW = 1024, SGG = 8, SGC = 128;
constexpr int INW = 9224, NZ = 9216;
constexpr int PEH = 8, PEK = 128, PED = 256, NEXP = 16384;
constexpr float EPS = 1e-6f;
constexpr int SKEYS = PAST + DSEQ, SBP = 4128;
constexpr int NTM = MT / 256;
constexpr float LOG2E = 1.4426950408889634f;

constexpr size_t O_Y = 0, O_KP = (size_t)MT * DM, O_VP = O_KP + (size_t)MP * FW, O_LFP = O_VP + (size_t)MP * FW, O_KS = O_LFP + (size_t)MP * FH,
                 O_VS = O_KS + (size_t)MS * FW, O_LFS = O_VS + (size_t)MS * FW, O_SGV = O_LFS + (size_t)MS * FH, O_END = O_SGV + (size_t)MS * SGW;
static_assert(O_END == 68552704, "output map");

constexpr size_t MiB = 1u << 20;
constexpr size_t WS_CTL = 0, CTL_BYTES = 1 * MiB;
constexpr size_t WS_WIN = 2 * MiB, WS_WAB = 38 * MiB, WS_WO = 46 * MiB, WS_WPQ = 54 * MiB, WS_SK = 62 * MiB, WS_WSP = 62 * MiB + 512 * 1024;
constexpr size_t WS_TU = 64 * MiB, WS_TV = 128 * MiB, WS_H = 192 * MiB, WS_Q = 257 * MiB, WS_QS = 289 * MiB, WS_K = 290 * MiB, WS_V = 322 * MiB;
constexpr size_t WS_US = 354 * MiB, WS_VS = 387 * MiB, WS_GA = 420 * MiB, WS_GB = 485 * MiB, WS_OA = 550 * MiB, WS_OB = WS_OA + (size_t)MT * FW * 2;
constexpr size_t WS_Y = 615 * MiB, WS_XG = 680 * MiB, WS_QN = 745 * MiB, WS_EI = 810 * MiB, WS_GW = 819 * MiB, WS_PB = 828 * MiB, WS_SB = 829 * MiB;
constexpr size_t WS_VSSQ = 832 * MiB, WS_XSSQ = 834 * MiB, WS_END = 837 * MiB;
constexpr size_t WS_X1 = WS_H;
static_assert(WS_X1 + (size_t)MT * DM * 4 <= WS_US, "x1 overlay");
static_assert(WS_OB + (size_t)MT * FW * 2 <= WS_Y && WS_H + (size_t)MT * DM * 2 <= WS_Q && WS_WIN + (size_t)NZ * DM * 2 <= WS_WAB, "ws map");

constexpr int LDS_BYTES = 160 * 1024, LDS_STAT = 128 * 1024, LDS_XB = LDS_BYTES - 64;
constexpr int CW_BAR = 1024, CW_CHAIN = 5120, NCHAIN = 8; constexpr size_t CTL_ZERO = 32 * 1024;
constexpr int NTHREADS = 512, NWAVES = 8;

__device__ __forceinline__ float wave_sum(float v) {
#pragma unroll
    for (int o = 1; o < 64; o <<= 1) v += __shfl_xor(v, o);
    return v;
}
#define DPP_STEP(v, ctrl, rmask) ((v) + __builtin_bit_cast(float, __builtin_amdgcn_update_dpp(0, __builtin_bit_cast(int, (v)), (ctrl), (rmask), 0xF, false)))
__device__ __forceinline__ float wave_sum_dpp(float v) {
    v = DPP_STEP(v, 0xB1, 0xF);
    v = DPP_STEP(v, 0x4E, 0xF);
    v = DPP_STEP(v, 0x141, 0xF);
    v = DPP_STEP(v, 0x140, 0xF);
    v = DPP_STEP(v, 0x142, 0xA);
    v = DPP_STEP(v, 0x143, 0xC);
    return __builtin_bit_cast(float, __builtin_amdgcn_readlane(__builtin_bit_cast(int, v), 63));
}
__device__ __forceinline__ unsigned pk2(float lo, float hi) { unsigned r; asm volatile("v_cvt_pk_bf16_f32 %0, %1, %2" : "=v"(r) : "v"(lo), "v"(hi)); return r; }
__device__ __forceinline__ float bflo(unsigned u) { return __uint_as_float(u << 16); }
__device__ __forceinline__ float bfhi(unsigned u) { return __uint_as_float(u & 0xffff0000u); }
__device__ __forceinline__ float gelu_tanh(float x) {
    const float u = 0.7978845608028654f * (x + 0.044715f * x * x * x);
    return x * __builtin_amdgcn_rcpf(1.0f + __builtin_amdgcn_exp2f(-2.0f * LOG2E * u));
}
__device__ __forceinline__ float sigmoidf_(float x) { return __builtin_amdgcn_rcpf(1.0f + __builtin_amdgcn_exp2f(-LOG2E * x)); }
__device__ __forceinline__ float log_sigmoid(float z) { return fminf(z, 0.f) - log1pf(expf(-fabsf(z))); }

struct Frame {
    LAS unsigned char* lds; unsigned char* lds_g;
    int tid, lane, wave, G, vcu, probe;
    const float* const* in;
    float* out; unsigned char* ws;
};
__device__ __forceinline__ const float* xrow(const Frame& F, int m) { return m < MP ? F.in[0] + (size_t)m * DM : F.in[1] + (size_t)(m - MP) * DM; }

__device__ __forceinline__ void p0_transpose_item(const float* W, int ldw, int K, hbf* WT, int nblk, int nsplit, int nskip, LAS float* scr, int item, int lane, const float* kg = nullptr) {
    const int kb = item / nblk, nb = item % nblk, k0 = 64 * kb, n0 = 32 * nb, s0 = n0 + (n0 >= nsplit ? nskip : 0);
#pragma unroll 8
    for (int i = 0; i < 32; ++i) { const int kk = 2 * i + (lane >> 5); float wv = W[(size_t)(k0 + kk) * ldw + s0 + (lane & 31)]; if (kg) wv *= kg[k0 + kk]; scr[kk * 33 + (lane & 31)] = wv; }
    asm volatile("s_waitcnt lgkmcnt(0)" ::: "memory");
    const int c = lane & 7;
#pragma unroll
    for (int j = 0; j < 4; ++j) { const int n = (lane >> 3) + 8 * j; const LAS float* s = scr + (8 * c) * 33 + n;
        v4u o; o.x = pk2(s[0 * 33], s[1 * 33]); o.y = pk2(s[2 * 33], s[3 * 33]); o.z = pk2(s[4 * 33], s[5 * 33]); o.w = pk2(s[6 * 33], s[7 * 33]);
        *(v4u*)(WT + (size_t)(n0 + n) * K + k0 + 8 * c) = o; }
    asm volatile("s_waitcnt lgkmcnt(0)" ::: "memory");
}
__device__ __forceinline__ void cvt8(const float* src, hbf* dst, size_t i8) {
    const f32x4 a = *(const f32x4*)(src + i8 * 8), b = *(const f32x4*)(src + i8 * 8 + 4);
    v4u o; o.x = pk2(a[0], a[1]); o.y = pk2(a[2], a[3]); o.z = pk2(b[0], b[1]); o.w = pk2(b[2], b[3]);
    *(v4u*)(dst + i8 * 8) = o;
}
__device__ __forceinline__ unsigned pk8_fp4(f32x4 a, f32x4 b, float sc) {
    unsigned p = 0;
    p = __builtin_amdgcn_cvt_scalef32_pk_fp4_f32(p, a[0] * sc, a[1] * sc, 1.0f, 0); p = __builtin_amdgcn_cvt_scalef32_pk_fp4_f32(p, a[2] * sc, a[3] * sc, 1.0f, 1);
    p = __builtin_amdgcn_cvt_scalef32_pk_fp4_f32(p, b[0] * sc, b[1] * sc, 1.0f, 2); p = __builtin_amdgcn_cvt_scalef32_pk_fp4_f32(p, b[2] * sc, b[3] * sc, 1.0f, 3);
    return p;
}
__device__ __forceinline__ void cvt32_fp4(const float* src, unsigned char* dst, size_t i32, float sc) {
    const f32x4* s4 = (const f32x4*)(src + i32 * 32);
    v4u o; o.x = pk8_fp4(s4[0], s4[1], sc); o.y = pk8_fp4(s4[2], s4[3], sc); o.z = pk8_fp4(s4[4], s4[5], sc); o.w = pk8_fp4(s4[6], s4[7], sc);
    *(v4u*)(dst + i32 * 16) = o;
}
constexpr int P0_I_IN = (DM / 64) * (NZ / 32), P0_I_A = (FW / 64) * (DM / 32), P0_I_O = (DM / 64) * (DM / 32);
#define P0_LATE_OK(F) ((F).G == 256)
__device__ __forceinline__ void late_weights(const Frame& F, LAS float* scr, int gw, int NGW) {
    constexpr int I_A = P0_I_A, I_O = P0_I_O;
    for (int it = gw; it < 2 * I_A + 2 * I_O; it += NGW) {
        int r = it;
        if (r < I_A) { p0_transpose_item(F.in[13], DM, FW, (hbf*)(F.ws + WS_WAB), DM / 32, 1 << 30, 0, scr, r, F.lane); continue; } r -= I_A;
        if (r < I_A) { p0_transpose_item(F.in[14], DM, FW, (hbf*)(F.ws + WS_WAB) + (size_t)DM * FW, DM / 32, 1 << 30, 0, scr, r, F.lane); continue; } r -= I_A;
        if (r < I_O) { p0_transpose_item(F.in[15], DM, DM, (hbf*)(F.ws + WS_WO), DM / 32, 1 << 30, 0, scr, r, F.lane); continue; } r -= I_O;
        p0_transpose_item(F.in[17], DM, DM, (hbf*)(F.ws + WS_WPQ), DM / 32, 1 << 30, 0, scr, r, F.lane, F.in[16]);
    }
}
__device__ __forceinline__ void phase0(const Frame& F) {
    LAS float* Wf = (LAS float*)F.lds;
    for (int k = F.tid; k < DM; k += NTHREADS) {
        const f32x4 a = *(const f32x4*)(F.in[6] + (size_t)k * INW + 3 * FW), b = *(const f32x4*)(F.in[6] + (size_t)k * INW + 3 * FW + 4);
        Wf[0 * DM + k] = a[0]; Wf[1 * DM + k] = a[1]; Wf[2 * DM + k] = a[2]; Wf[3 * DM + k] = a[3];
        Wf[4 * DM + k] = b[0]; Wf[5 * DM + k] = b[1]; Wf[6 * DM + k] = b[2]; Wf[7 * DM + k] = b[3];
    }
    __syncthreads();
    const int gw = F.vcu * NWAVES + F.wave, NGW = F.G * NWAVES;
    hbf* H = (hbf*)(F.ws + WS_H);
    for (int m = gw; m < MT; m += NGW) {
        const f32x4* xr = (const f32x4*)xrow(F, m) + F.lane;
        f32x4 v[8]; float ss = 0.f;
#pragma unroll
        for (int j = 0; j < 8; ++j) { v[j] = xr[64 * j]; ss += (v[j][0] * v[j][0] + v[j][1] * v[j][1]) + (v[j][2] * v[j][2] + v[j][3] * v[j][3]); }
        const float rstd = 1.0f / sqrtf(wave_sum_dpp(ss) * (1.0f / DM) + EPS);
        float fl[8];
#pragma unroll
        for (int q = 0; q < 8; ++q) fl[q] = 0.f;
#pragma unroll
        for (int j = 0; j < 8; ++j) {
            const f32x4 g = ((const f32x4*)F.in[5])[64 * j + F.lane];
            v[j] = v[j] * rstd * g;
            v2u o; o.x = pk2(v[j][0], v[j][1]); o.y = pk2(v[j][2], v[j][3]);
            *(v2u*)(H + (size_t)m * DM + 4 * (64 * j + F.lane)) = o;
#pragma unroll
            for (int q = 0; q < 8; ++q) { const f32x4 w = *(const LAS f32x4*)(Wf + q * DM + 4 * (64 * j + F.lane)); fl[q] += (v[j][0] * w[0] + v[j][1] * w[1]) + (v[j][2] * w[2] + v[j][3] * w[3]); }
        }
        float mine = 0.f;
#pragma unroll
        for (int q = 0; q < 8; ++q) { const float s = wave_sum_dpp(fl[q]); if (F.lane == q) mine = s; }
        if (F.lane < 8) { const float lf = log_sigmoid(mine + F.in[7][F.lane]);
            if (m < MP) F.out[O_LFP + (size_t)m * FH + F.lane] = lf; else F.out[O_LFS + (size_t)(m - MP) * FH + F.lane] = lf; }
    }
    LAS float* scr = (LAS float*)(F.lds + 65536 + F.wave * 8448);
    for (int it = gw + (MT - gw + NGW - 1) / NGW * NGW - MT; it < P0_I_IN; it += NGW) p0_transpose_item(F.in[6], INW, DM, (hbf*)(F.ws + WS_WIN), NZ / 32, 3 * FW, 8, scr, it, F.lane);
    if (!P0_LATE_OK(F)) late_weights(F, scr, gw, NGW);
    const size_t gt = (size_t)F.vcu * NTHREADS + F.tid, NGT = (size_t)F.G * NTHREADS;
    for (size_t i = gt; i < (size_t)PEH * 2 * PEK * 128 / 8; i += NGT) cvt8(F.in[19], (hbf*)(F.ws + WS_SK), i);
    for (size_t i = gt; i < (size_t)SGG * SGC * SGC / 8; i += NGT) {
        const int row = (int)((i * 8) / SGC) % SGC, c0 = (int)((i * 8) % SGC);
        const f32x4 a = *(const f32x4*)(F.in[11] + i * 8), b = *(const f32x4*)(F.in[11] + i * 8 + 4);
        float t[8] = {a[0], a[1], a[2], a[3], b[0], b[1], b[2], b[3]};
#pragma unroll
        for (int e = 0; e < 8; ++e) if (c0 + e > row) t[e] = 0.f;
        v4u o; o.x = pk2(t[0], t[1]); o.y = pk2(t[2], t[3]); o.z = pk2(t[4], t[5]); o.w = pk2(t[6], t[7]);
        *(v4u*)((hbf*)(F.ws + WS_WSP) + i * 8) = o;
    }
}

__device__ __forceinline__ void convert_tables(const Frame& F, int rank, int nranks, size_t lo = 0, size_t hi = (size_t)NEXP * DM / 32) {
    const size_t gt = (size_t)rank * NTHREADS + F.tid, NGT = (size_t)nranks * NTHREADS;
    for (size_t i = lo + gt; i < hi; i += NGT) { cvt32_fp4(F.in[20], F.ws + WS_TU, i, 64.f); cvt32_fp4(F.in[21], F.ws + WS_TV, i, 16.f); }
}
constexpr int CW_CV = 6400, CW_P7 = 6464, CV_CHUNK = 1024;
__device__ __forceinline__ void convert_tables_dyn(const Frame& F, size_t lo) {
    constexpr size_t HI = (size_t)NEXP * DM / 32;
    LAS int* slot = (LAS int*)(F.lds + 64);
    unsigned* ctr = (unsigned*)(F.ws + WS_CTL) + CW_CV;
    __syncthreads();
    if (F.tid == 0) slot[0] = (int)atomicAdd(ctr, 1u);
    __syncthreads();
    int c = __builtin_amdgcn_readfirstlane(slot[0]), par = 1;
    while (lo + (size_t)c * CV_CHUNK < HI) {
        unsigned nx = 0; if (F.tid == 0) nx = atomicAdd(ctr, 1u);
        const size_t base = lo + (size_t)c * CV_CHUNK;
#pragma unroll
        for (int k = 0; k < CV_CHUNK / NTHREADS; ++k) { const size_t i = base + k * NTHREADS + F.tid; if (i < HI) { cvt32_fp4(F.in[20], F.ws + WS_TU, i, 64.f); cvt32_fp4(F.in[21], F.ws + WS_TV, i, 16.f); } }
        if (F.tid == 0) slot[par] = (int)nx;
        __syncthreads();
        c = __builtin_amdgcn_readfirstlane(slot[par]); par ^= 1;
    }
}
__device__ __forceinline__ void phase1_scan(const Frame& F, int unit) {
    LAS float* part = (LAS float*)F.lds;
    const int h = F.tid & 7, ch = F.tid >> 3;
    if (unit < NBATCH) {
        const float* lf = F.out + O_LFP + (size_t)unit * SEQ * FH;
        float* pb = (float*)(F.ws + WS_PB) + ((size_t)unit * FH + h) * SEQ;
        float s = 0.f;
        for (int i = 0; i < 128; ++i) s += lf[(size_t)(ch * 128 + i) * FH + h];
        part[ch * 8 + h] = s; __syncthreads();
        float base = 0.f; for (int c = 0; c < ch; ++c) base += part[c * 8 + h];
        constexpr float INV = 11.313708498984761f;
        for (int i = 0; i < 128; ++i) { base += lf[(size_t)(ch * 128 + i) * FH + h]; pb[ch * 128 + i] = -base * INV; }
        __syncthreads();
    } else {
        const int bb = unit - NBATCH;
        const float* lf = F.in[4] + (size_t)bb * PAST * FH;
        float* sb = (float*)(F.ws + WS_SB) + ((size_t)bb * FH + h) * SBP;
        float s = 0.f;
        for (int i = 0; i < 64; ++i) s += lf[(size_t)(ch * 64 + i) * FH + h];
        part[ch * 8 + h] = s; __syncthreads();
        float suf = 0.f; for (int c = ch + 1; c < 64; ++c) suf += part[c * 8 + h];
        for (int i = 63; i >= 0; --i) { sb[ch * 64 + i] = suf; suf += lf[(size_t)(ch * 64 + i) * FH + h]; }
        if (ch == 0) { const float* ln = F.out + O_LFS + (size_t)bb * DSEQ * FH; float a = 0.f;
            for (int i = 0; i < DSEQ; ++i) { a += ln[i * FH + h]; sb[PAST + i] = -a; }
            for (int i = DSEQ; i < SBP - PAST; ++i) sb[PAST + i] = 0.f; }
        __syncthreads();
    }
}
#define XB_TMO      128
#define XB_XCNT(j)  (256  + 64 * (j))
#define XB_XSUB(j)  (1280 + 64 * (j))
#define XB_XGEN(j)  (2304 + 64 * (j))
#define XB_TOP      3328
#define XB_TOPGEN   3392
#define XCD_BAR_WORDS 3456
#define XB_SPIN_CAP (1u << 18)

__device__ __forceinline__ unsigned xb_ld(unsigned* p)              { return __hip_atomic_load(p, __ATOMIC_RELAXED, __HIP_MEMORY_SCOPE_AGENT); }
__device__ __forceinline__ unsigned xb_add(unsigned* p, unsigned v) { return __hip_atomic_fetch_add(p, v, __ATOMIC_RELAXED, __HIP_MEMORY_SCOPE_AGENT); }
__device__ __forceinline__ unsigned xb_xcc_id() { return (unsigned)__builtin_amdgcn_s_getreg((3 << 11) | 20) & 0xFu; }
#define XB_SPIN(cond, bar) do { unsigned _sp = 0; while (cond) { __builtin_amdgcn_s_sleep(1); \
    if ((++_sp & 255u) == 0u) { if (xb_ld(&(bar)[XB_TMO])) break; if (_sp > XB_SPIN_CAP) { atomicAdd(&(bar)[XB_TMO], 1u); break; } } } } while (0)

struct XcdBarrier {
    unsigned* bar; unsigned x;
    volatile LAS unsigned* st;
};

__device__ __forceinline__ XcdBarrier xcd_barrier_post(unsigned* bar, volatile LAS unsigned* st) {
    XcdBarrier b; b.bar = bar; b.x = xb_xcc_id(); b.st = st;
    if (threadIdx.x == 0) st[2] = xb_add(&bar[XB_XCNT(b.x)], 1u);
    return b;
}
__device__ __forceinline__ void xcd_barrier_complete(unsigned* bar, unsigned x, unsigned& nloc, unsigned& nx) {
    const unsigned G = gridDim.x * gridDim.y * gridDim.z;
    unsigned sum, cnt, mine, sp = 0u;
    for (;;) {
        sum = 0u; cnt = 0u; mine = 0u;
#pragma unroll
        for (unsigned j = 0; j < 16; ++j) { const unsigned c = xb_ld(&bar[XB_XCNT(j)]); sum += c; cnt += (c > 0u) ? 1u : 0u; mine = (j == x) ? c : mine; }
        if (sum == G) break;
        __builtin_amdgcn_s_sleep(1);
        if ((++sp & 255u) == 0u) { if (xb_ld(&bar[XB_TMO])) break; if (sp > XB_SPIN_CAP) { atomicAdd(&bar[XB_TMO], 1u); break; } }
    }
    nloc = mine > 0u ? mine : 1u; nx = cnt > 0u ? cnt : 1u;
}

__device__ __forceinline__ void xcd_barrier(const XcdBarrier& b) {
    asm volatile("s_waitcnt vmcnt(0)" ::: "memory");
    __syncthreads();
    if (threadIdx.x == 0) {
        unsigned* bar = b.bar;
        __builtin_amdgcn_s_waitcnt(0);
        unsigned nloc = b.st[0], nx = b.st[1];
        if (nloc == 0u) { xcd_barrier_complete(bar, b.x, nloc, nx); b.st[0] = nloc; b.st[1] = nx; }
        const unsigned old = xb_add(&bar[XB_XSUB(b.x)], 1u);
        const unsigned gen = old / nloc;
        if (old + 1u == (gen + 1u) * nloc) {
            __builtin_amdgcn_fence(__ATOMIC_RELEASE, "agent");
            asm volatile("s_waitcnt vmcnt(0)" ::: "memory");
            const unsigned og = xb_add(&bar[XB_TOP], 1u);
            const unsigned tg = og / nx;
            if (og + 1u == (tg + 1u) * nx) xb_add(&bar[XB_TOPGEN], 1u);
            else XB_SPIN(xb_ld(&bar[XB_TOPGEN]) == tg, bar);
            __builtin_amdgcn_fence(__ATOMIC_ACQUIRE, "agent");
            xb_add(&bar[XB_XGEN(b.x)], 1u);
            asm volatile("s_waitcnt vmcnt(0)" ::: "memory");
        } else {
            XB_SPIN(xb_ld(&bar[XB_XGEN(b.x)]) == gen, bar);
            __builtin_amdgcn_fence(__ATOMIC_ACQUIRE, "agent");
            asm volatile("s_waitcnt vmcnt(0)" ::: "memory");
        }
    }
    __syncthreads();
}

__device__ __forceinline__ void chain_barrier(unsigned* cnt, unsigned k) {
    asm volatile("s_waitcnt vmcnt(0)" ::: "memory");
    __syncthreads();
    if (threadIdx.x == 0) {
        __builtin_amdgcn_fence(__ATOMIC_RELEASE, "agent");
        asm volatile("s_waitcnt vmcnt(0)" ::: "memory");
        (void)xb_add(cnt, 1u);
        const unsigned want = (unsigned)NCHAIN * (k + 1u); unsigned sp = 0u;
        while (xb_ld(cnt) < want) { __builtin_amdgcn_s_sleep(1); if (++sp > (1u << 22)) break; }
        __builtin_amdgcn_fence(__ATOMIC_ACQUIRE, "agent");
        asm volatile("s_waitcnt vmcnt(0)" ::: "memory");
    }
    __syncthreads();
}
#define EPI_BAR() do { asm volatile("s_waitcnt lgkmcnt(0)" ::: "memory"); __builtin_amdgcn_s_barrier(); asm volatile("" ::: "memory"); } while (0)
__device__ __forceinline__ v4u pack8f(const float* v) { v4u o; o.x = pk2(v[0], v[1]); o.y = pk2(v[2], v[3]); o.z = pk2(v[4], v[5]); o.w = pk2(v[6], v[7]); return o; }

struct EpiIn {
    static constexpr bool PERM = true, AFTER_DRAIN = false;
    hbf *Qp, *Qs, *Kp, *Vp, *US, *VS, *GA, *GB; float* out; float* VSSQ; const float *qg, *kg; LAS float* P; int noepi = 0;
    __device__ __forceinline__ void operator()(const pg8::f32x4 (&acc)[2][2][4][2], const pg8::Unit& u, int wr, int wc, int fr, int fq) const {
#ifdef PROBE_NOEPI
        if (noepi) return;
#endif
        const int pn = u.pn, sec = pn < 20 ? (pn >> 2) : (pn < 28 ? 5 : 6);
        const bool sample = (u.pm == NTM - 1);
        if (sec <= 1) {
#pragma unroll
            for (int ai = 0; ai < 2; ++ai)
#pragma unroll
                for (int m = 0; m < 4; ++m)
#pragma unroll
                    for (int bj = 0; bj < 2; ++bj) {
                        const f32x4 a = acc[ai][bj][m][0], b = acc[ai][bj][m][1];
                        float s = (a[0] * a[0] + a[1] * a[1]) + (a[2] * a[2] + a[3] * a[3]) + (b[0] * b[0] + b[1] * b[1]) + (b[2] * b[2] + b[3] * b[3]);
                        s += __shfl_xor(s, 16); s += __shfl_xor(s, 32);
                        const int rl = ai * 128 + wr * 64 + m * 16 + fr;
                        if (fq == 0) P[(rl * 2 + bj) * 4 + wc] = s;
                        asm volatile("" ::: "memory");
                    }
            EPI_BAR();
            const float* gsrc = (sec == 0 ? qg : kg) + wc * 32 + 8 * fq;
            const f32x4 g0 = *(const f32x4*)gsrc, g1 = *(const f32x4*)(gsrc + 4);
#pragma unroll
            for (int ai = 0; ai < 2; ++ai)
#pragma unroll
                for (int m = 0; m < 4; ++m) {
                    const int rl = ai * 128 + wr * 64 + m * 16 + fr, tok = u.pm * 256 + rl;
#pragma unroll
                    for (int bj = 0; bj < 2; ++bj) {
                        const f32x4 p4 = *(const LAS f32x4*)(P + (rl * 2 + bj) * 4);
                        const float rstd = 1.0f / sqrtf(((p4[0] + p4[1]) + (p4[2] + p4[3])) * (1.0f / FD) + EPS);
                        const f32x4 a = acc[ai][bj][m][0] * rstd * g0, b = acc[ai][bj][m][1] * rstd * g1;
                        const float v[8] = {a[0], a[1], a[2], a[3], b[0], b[1], b[2], b[3]};
                        const int head = (pn & 3) * 2 + bj, d0 = wc * 32 + 8 * fq;
                        if (sec == 0) {
                            hbf* dst = sample ? Qs + ((size_t)(((tok - MP) >> 4) * FH + head) * DSEQ + ((tok - MP) & 15)) * FD + d0
                                              : Qp + ((size_t)((tok >> 13) * FH + head) * SEQ + (tok & (SEQ - 1))) * FD + d0;
                            *(v4u*)dst = pack8f(v);
                        } else {
                            float* o = sample ? out + O_KS + (size_t)(tok - MP) * FW + head * FD + d0 : out + O_KP + (size_t)tok * FW + head * FD + d0;
                            *(f32x4*)o = a; *(f32x4*)(o + 4) = b;
                            if (!sample) *(v4u*)(Kp + ((size_t)((tok >> 13) * FH + head) * SEQ + (tok & (SEQ - 1))) * FD + d0) = pack8f(v);
                        }
                    }
                    asm volatile("" ::: "memory");
                }
        } else if (sec == 2) {
#pragma unroll
            for (int ai = 0; ai < 2; ++ai)
#pragma unroll
                for (int m = 0; m < 4; ++m) {
                    const int rl = ai * 128 + wr * 64 + m * 16 + fr, tok = u.pm * 256 + rl;
#pragma unroll
                    for (int bj = 0; bj < 2; ++bj) {
                        const f32x4 a = acc[ai][bj][m][0], b = acc[ai][bj][m][1];
                        const float v[8] = {a[0], a[1], a[2], a[3], b[0], b[1], b[2], b[3]};
                        const int head = (pn & 3) * 2 + bj, d0 = wc * 32 + 8 * fq;
                        float* o = sample ? out + O_VS + (size_t)(tok - MP) * FW + head * FD + d0 : out + O_VP + (size_t)tok * FW + head * FD + d0;
                        *(f32x4*)o = a; *(f32x4*)(o + 4) = b;
                        if (!sample) *(v4u*)(Vp + ((size_t)((tok >> 13) * FH + head) * SEQ + (tok & (SEQ - 1))) * FD + d0) = pack8f(v);
                    }
                }
        } else if (sec == 3 || sec == 4) {
            hbf* dstb = sec == 3 ? US : VS;
#pragma unroll
            for (int ai = 0; ai < 2; ++ai)
#pragma unroll
                for (int m = 0; m < 4; ++m) {
                    const int rl = ai * 128 + wr * 64 + m * 16 + fr, tok = u.pm * 256 + rl;
                    float ss = 0.f;
#pragma unroll
                    for (int bj = 0; bj < 2; ++bj) {
                        float v[8];
#pragma unroll
                        for (int e = 0; e < 4; ++e) { v[e] = gelu_tanh(acc[ai][bj][m][0][e]); v[4 + e] = gelu_tanh(acc[ai][bj][m][1][e]); }
#pragma unroll
                        for (int e = 0; e < 8; ++e) ss += v[e] * v[e];
                        *(v4u*)(dstb + (size_t)tok * SGW + (pn & 3) * 256 + bj * 128 + wc * 32 + 8 * fq) = pack8f(v);
                    }
                    if (sec == 4) { ss += __shfl_xor(ss, 16); ss += __shfl_xor(ss, 32); if (fq == 0) VSSQ[(size_t)tok * 16 + (pn & 3) * 4 + wc] = ss; }
                }
        } else {
            hbf* dstb = sec == 5 ? GA : GB; const int c0 = (sec == 5 ? pn - 20 : pn - 28) * 256;
#pragma unroll
            for (int ai = 0; ai < 2; ++ai)
#pragma unroll
                for (int m = 0; m < 4; ++m) {
                    const int rl = ai * 128 + wr * 64 + m * 16 + fr, tok = u.pm * 256 + rl;
#pragma unroll
                    for (int bj = 0; bj < 2; ++bj) {
                        float v[8];
#pragma unroll
                        for (int e = 0; e < 4; ++e) { v[e] = sigmoidf_(acc[ai][bj][m][0][e]); v[4 + e] = sigmoidf_(acc[ai][bj][m][1][e]); }
                        *(v4u*)(dstb + (size_t)tok * DM + c0 + bj * 128 + wc * 32 + 8 * fq) = pack8f(v);
                    }
                }
        }
    }
};

struct MergeOrder {
    int G, c, lo, hi;
    __device__ __forceinline__ bool next(int i, pg8::Unit& u) const {
        const int t = lo + (i >> 1) * G + c; if (t >= hi) return false;
        u.pm = t >> 3; u.pn = t & 7; if (i & 1) { u.pm += NTM; u.pn += 8; } return true;
    }
    __device__ __forceinline__ void a_ready(const pg8::Unit&) const {}
    __device__ __forceinline__ void done(const pg8::Unit&) const {}
};
struct OneTile {
    int pm, pn;
    __device__ __forceinline__ bool next(int i, pg8::Unit& u) const { if (i > 0) return false; u.pm = pm; u.pn = pn; return true; }
    __device__ __forceinline__ void a_ready(const pg8::Unit&) const {}
    __device__ __forceinline__ void done(const pg8::Unit&) const {}
};
struct TileOrder {
    pg8::StaticOrder so; bool chain; int ci;
    __device__ __forceinline__ bool next(int i, pg8::Unit& u) const {
        if (!chain) return so.next(i, u);
        if (i > 0) return false; u.pm = NTM - 1; u.pn = ci; return true;
    }
    __device__ __forceinline__ void a_ready(const pg8::Unit&) const {}
    __device__ __forceinline__ void done(const pg8::Unit&) const {}
};
struct EpiMerge {
    static constexpr bool PERM = true, AFTER_DRAIN = false;
    const hbf *GA, *GB; hbf* Y;
    __device__ __forceinline__ void operator()(const pg8::f32x4 (&acc)[2][2][4][2], const pg8::Unit& u, int wr, int wc, int fr, int fq) const {
        const bool isb = u.pn >= 8; const int pm = isb ? u.pm - NTM : u.pm, pn = u.pn & 7; const hbf* G = isb ? GB : GA;
#pragma unroll
        for (int ai = 0; ai < 2; ++ai)
#pragma unroll
            for (int m = 0; m < 4; ++m) {
                const int tok = pm * 256 + ai * 128 + wr * 64 + m * 16 + fr;
#pragma unroll
                for (int bj = 0; bj < 2; ++bj) {
                    const size_t off = (size_t)tok * DM + pn * 256 + bj * 128 + wc * 32 + 8 * fq;
                    const v4u g = *(const v4u*)(G + off);
                    const f32x4 a = acc[ai][bj][m][0], b = acc[ai][bj][m][1];
                    float v[8] = {a[0] * bflo(g.x), a[1] * bfhi(g.x), a[2] * bflo(g.y), a[3] * bfhi(g.y), b[0] * bflo(g.z), b[1] * bfhi(g.z), b[2] * bflo(g.w), b[3] * bfhi(g.w)};
                    if (isb) { const v4u y = *(const v4u*)(Y + off);
                        v[0] += bflo(y.x); v[1] += bfhi(y.x); v[2] += bflo(y.y); v[3] += bfhi(y.y); v[4] += bflo(y.z); v[5] += bfhi(y.z); v[6] += bflo(y.w); v[7] += bfhi(y.w); }
                    *(v4u*)(Y + off) = pack8f(v);
                }
            }
    }
};

struct EpiOut {
    static constexpr bool PERM = true, AFTER_DRAIN = false;
    const float *xp, *xs; hbf* XB; float* XSSQ;
    __device__ __forceinline__ void operator()(const pg8::f32x4 (&acc)[2][2][4][2], const pg8::Unit& u, int wr, int wc, int fr, int fq) const {
#pragma unroll
        for (int ai = 0; ai < 2; ++ai)
#pragma unroll
            for (int m = 0; m < 4; ++m) {
                const int tok = u.pm * 256 + ai * 128 + wr * 64 + m * 16 + fr;
                const float* xr = tok < MP ? xp + (size_t)tok * DM : xs + (size_t)(tok - MP) * DM;
                float ss = 0.f;
#pragma unroll
                for (int bj = 0; bj < 2; ++bj) {
                    const int col = u.pn * 256 + bj * 128 + wc * 32 + 8 * fq;
                    const f32x4 a = acc[ai][bj][m][0] + *(const f32x4*)(xr + col), b = acc[ai][bj][m][1] + *(const f32x4*)(xr + col + 4);
                    ss += (a[0] * a[0] + a[1] * a[1]) + (a[2] * a[2] + a[3] * a[3]) + (b[0] * b[0] + b[1] * b[1]) + (b[2] * b[2] + b[3] * b[3]);
                    const float v[8] = {a[0], a[1], a[2], a[3], b[0], b[1], b[2], b[3]};
                    *(v4u*)(XB + (size_t)tok * DM + col) = pack8f(v);
                }
                ss += __shfl_xor(ss, 16); ss += __shfl_xor(ss, 32);
                if (fq == 0) XSSQ[(size_t)tok * 32 + u.pn * 4 + wc] = ss;
            }
    }
};

struct EpiPeerQ {
    static constexpr bool PERM = true, AFTER_DRAIN = false;
    const float* XSSQ; const float* pqg; hbf* QN; LAS float* P;
    __device__ __forceinline__ void operator()(const pg8::f32x4 (&acc)[2][2][4][2], const pg8::Unit& u, int wr, int wc, int fr, int fq) const {
        LAS float* R = P + 2048;
        const int tid = threadIdx.x;
        if (tid < 256) { const f32x4* s = (const f32x4*)(XSSQ + (size_t)(u.pm * 256 + tid) * 32); float t = 0.f;
#pragma unroll
            for (int k = 0; k < 8; ++k) { const f32x4 q = s[k]; t += (q[0] + q[1]) + (q[2] + q[3]); }
            R[tid] = 1.0f / sqrtf(t * (1.0f / DM) + EPS); }
#pragma unroll
        for (int ai = 0; ai < 2; ++ai)
#pragma unroll
            for (int m = 0; m < 4; ++m)
#pragma unroll
                for (int bj = 0; bj < 2; ++bj) {
                    const f32x4 a = acc[ai][bj][m][0], b = acc[ai][bj][m][1];
                    float s = (a[0] * a[0] + a[1] * a[1]) + (a[2] * a[2] + a[3] * a[3]) + (b[0] * b[0] + b[1] * b[1]) + (b[2] * b[2] + b[3] * b[3]);
                    s += __shfl_xor(s, 16); s += __shfl_xor(s, 32);
                    const int rl = ai * 128 + wr * 64 + m * 16 + fr;
                    if (fq == 0) P[rl * 8 + bj * 4 + wc] = s;
                    asm volatile("" ::: "memory");
                }
        EPI_BAR();
#pragma unroll
        for (int ai = 0; ai < 2; ++ai)
#pragma unroll
            for (int m = 0; m < 4; ++m) {
                const int rl = ai * 128 + wr * 64 + m * 16 + fr, tok = u.pm * 256 + rl;
                const f32x4 p0 = *(const LAS f32x4*)(P + rl * 8), p1 = *(const LAS f32x4*)(P + rl * 8 + 4);
                const float rx = R[rl];
                const float ssq = ((p0[0] + p0[1]) + (p0[2] + p0[3]) + (p1[0] + p1[1]) + (p1[2] + p1[3])) * rx * rx;
                const float sc = rx / sqrtf(ssq * (1.0f / PED) + EPS);
#pragma unroll
                for (int bj = 0; bj < 2; ++bj) {
                    const int d0 = bj * 128 + wc * 32 + 8 * fq;
                    const f32x4 g0 = *(const f32x4*)(pqg + d0), g1 = *(const f32x4*)(pqg + d0 + 4);
                    const f32x4 a = acc[ai][bj][m][0] * sc * g0, b = acc[ai][bj][m][1] * sc * g1;
                    const float v[8] = {a[0], a[1], a[2], a[3], b[0], b[1], b[2], b[3]};
                    *(v4u*)(QN + (size_t)tok * DM + u.pn * PED + d0) = pack8f(v);
                }
                asm volatile("" ::: "memory");
            }
    }
};
#define MFMA16(a, b, c) __builtin_amdgcn_mfma_f32_16x16x32_bf16((a), (b), (c), 0, 0, 0)
#define MFMA32(a, b, c) __builtin_amdgcn_mfma_f32_32x32x16_bf16((a), (b), (c), 0, 0, 0)
constexpr int ATT_BIAS_OFF = 69632;

constexpr int Q_SAMPLE = DBATCH * FH, Q_PROMPT = NBATCH * FH * (SEQ / 256), Q_SGS = Q_SAMPLE + Q_PROMPT, Q_SGP = Q_SGS + DBATCH * 8, Q_SGU = DBATCH * 8 + 1024, Q_END = Q_SGP + 1024;
#ifndef DECAY_SKIP
#define DECAY_SKIP 1
#endif
constexpr int CW_Q = 6144;
constexpr int LDS_POP = LDS_BYTES - 128, LDS_MX = LDS_BYTES - 256;
__device__ __forceinline__ int p2_pop(const Frame& F) {
    LAS int* slot = (LAS int*)(F.lds + LDS_POP);
    __syncthreads();
    if (F.tid == 0) *slot = (int)atomicAdd((unsigned*)(F.ws + WS_CTL) + CW_Q, 1u);
    __syncthreads();
    return __builtin_amdgcn_readfirstlane(*slot);
}
__device__ __forceinline__ float attn_skip_threshold(const Frame& F) {
    LAS unsigned* mx = (LAS unsigned*)(F.lds + LDS_MX);
    __syncthreads();
    if (F.tid < 2) mx[F.tid] = 0u;
    __syncthreads();
    if (F.tid < FD) { atomicMax((unsigned*)(mx + 0), __float_as_uint(fabsf(F.in[8][F.tid]))); atomicMax((unsigned*)(mx + 1), __float_as_uint(fabsf(F.in[9][F.tid]))); }
    __syncthreads();
    const float sb = 11.313708498984761f * __uint_as_float(mx[0]) * __uint_as_float(mx[1]) * 1.01f;
    const float tv = -(88.0f + 2.0f * sb) * 11.313708498984761f; float ts;
    if (F.tid == 0) ((LAS float*)mx)[2] = tv;
    asm volatile("v_readfirstlane_b32 %0, %1" : "=s"(ts) : "v"(tv));
    return ts;
}
__device__ __forceinline__ attn::BlockRef<attn::bf16, attn::bf16> attn_prompt_ref(const Frame& F, int idx, float thr_raw  ) {
    using namespace attn;
    const int qb = 31 - (idx >> 4), bh = idx & 15, P0 = qb * QB;
    const float* pb = (const float*)(F.ws + WS_PB) + (size_t)bh * SEQ;
    float* bias_lds = (float*)((char*)F.lds_g + ATT_BIAS_OFF);
    int t_ = threadIdx.x; asm volatile("" : "+v"(t_));
    for (int i = t_; i < (P0 + 256) / 4; i += NTHREADS) *(f32x4*)(bias_lds + 4 * i) = *(const f32x4*)(pb + 4 * i);
    __syncthreads();
    const float p0v = bias_lds[P0];
    thr_raw = ((LAS float*)(F.lds + LDS_MX))[2];
    const int l_ = t_ & 63, nt_ = P0 / KVBLK;
    const bool s_lo = (l_ < nt_) && (bias_lds[KVBLK * l_ + KVBLK - 1] - p0v < thr_raw);
    const bool s_hi = (l_ + 64 < nt_) && (bias_lds[KVBLK * (l_ + 64) + KVBLK - 1] - p0v < thr_raw);
    const unsigned long long b_lo = __ballot(s_lo), b_hi = __ballot(s_hi);
    const int run_lo = (~b_lo == 0ull) ? 64 : (int)__builtin_ctzll(~b_lo), run_hi = (~b_hi == 0ull) ? 64 : (int)__builtin_ctzll(~b_hi);
    const int jlo = __builtin_amdgcn_readfirstlane(run_lo < 64 ? run_lo : 64 + run_hi);
    BlockRef<bf16, bf16> r;
    r.Q = (const bf16*)(F.ws + WS_Q) + ((size_t)bh * SEQ + P0) * D; r.K = (const bf16*)(F.ws + WS_K) + (size_t)bh * SEQ * D; r.V = (const bf16*)(F.ws + WS_V) + (size_t)bh * SEQ * D;
    r.O = (bf16*)(F.ws + WS_OA) + ((size_t)(bh >> 3) * SEQ + P0) * OSTR + (bh & 7) * D; r.P0 = P0; r.jlo = jlo;
    return r;
}

__device__ __forceinline__ bf16x8 packf8(f32x4 a, f32x4 b) { v4u w; w.x = pk2(a[0], a[1]); w.y = pk2(a[2], a[3]); w.z = pk2(b[0], b[1]); w.w = pk2(b[2], b[3]); return __builtin_bit_cast(bf16x8, w); }
__device__ __forceinline__ void attn_sample_unit(const Frame& F, int unit) {
    int tid_ = threadIdx.x; asm volatile("" : "+v"(tid_)); const int lane_ = tid_ & 63;
    const int bb = unit >> 3, h = unit & 7, r = lane_ & 15, g = lane_ >> 4;
    const hbf* qrow = (const hbf*)(F.ws + WS_QS) + ((size_t)(bb * FH + h) * DSEQ + r) * FD;
    bf16x8 qf[4];
#pragma unroll
    for (int ks = 0; ks < 4; ++ks) { const v2u lo = *(const v2u*)(qrow + 32 * ks + 4 * g), hi = *(const v2u*)(qrow + 32 * ks + 16 + 4 * g);
        v4u w; w.x = lo.x; w.y = lo.y; w.z = hi.x; w.w = hi.y; qf[ks] = __builtin_bit_cast(bf16x8, w); }
    float mrun = -1e30f, lrun = 0.f; f32x4 o[2][4];
#pragma unroll
    for (int a = 0; a < 2; ++a)
#pragma unroll
        for (int b = 0; b < 4; ++b) o[a][b] = (f32x4){0.f, 0.f, 0.f, 0.f};
    const float* kc = F.in[2] + ((size_t)bb * PAST * FH + h) * FD;
    const float* vc = F.in[3] + ((size_t)bb * PAST * FH + h) * FD;
    const float* kn = F.out + O_KS + ((size_t)bb * DSEQ * FH + h) * FD;
    const float* vn = F.out + O_VS + ((size_t)bb * DSEQ * FH + h) * FD;
    const float* sb = (const float*)(F.ws + WS_SB) + (size_t)(bb * FH + h) * SBP;
    constexpr float C2 = 0.08838834764831845f * LOG2E;
    bool spec = true;
    f32x4 kv[2][4][2], vv[2][8];
#define SA_LOADK(t_) do { const bool nw_ = ((t_) == 128); const float* kb_ = nw_ ? kn : kc + (size_t)(t_) * 32 * FW; \
        _Pragma("unroll") for (int kb = 0; kb < 2; ++kb) { int key = 16 * kb + r; if (nw_ && key > 15) key = 15; \
            _Pragma("unroll") for (int ks = 0; ks < 4; ++ks) _Pragma("unroll") for (int i = 0; i < 2; ++i) kv[kb][ks][i] = *(const f32x4*)(kb_ + (size_t)key * FW + 32 * ks + 16 * i + 4 * g); } } while (0)
#define SA_LOADV(t_) do { const bool nw_ = ((t_) == 128); const float* vb_ = nw_ ? vn : vc + (size_t)(t_) * 32 * FW; \
        _Pragma("unroll") for (int j = 0; j < 8; ++j) { int key = 16 * (j >> 2) + 4 * g + (j & 3); if (nw_ && key > 15) key = 15; \
            _Pragma("unroll") for (int grp = 0; grp < 2; ++grp) vv[grp][j] = *(const f32x4*)(vb_ + (size_t)key * FW + 64 * grp + 4 * r); } } while (0)
#pragma unroll 1
    for (int t = 128 - F.wave; t >= 0; t -= NWAVES) {
        const bool isnew = (t == 128), near = spec;
        SA_LOADK(t);
        if (near) SA_LOADV(t);
        const f32x4 bs0 = *(const f32x4*)(sb + t * 32 + 4 * g), bs1 = *(const f32x4*)(sb + t * 32 + 16 + 4 * g);
        f32x4 s0 = {0.f, 0.f, 0.f, 0.f}, s1 = {0.f, 0.f, 0.f, 0.f};
#pragma unroll
        for (int ks = 0; ks < 4; ++ks) { s0 = MFMA16(packf8(kv[0][ks][0], kv[0][ks][1]), qf[ks], s0); s1 = MFMA16(packf8(kv[1][ks][0], kv[1][ks][1]), qf[ks], s1); }
        float x[8];
#pragma unroll
        for (int i = 0; i < 4; ++i) { x[i] = s0[i] * C2 + bs0[i] * LOG2E; x[4 + i] = s1[i] * C2 + bs1[i] * LOG2E; }
        if (isnew) {
#pragma unroll
            for (int i = 0; i < 4; ++i) { if (4 * g + i > r) x[i] = -__builtin_inff(); x[4 + i] = -__builtin_inff(); }
        }
        float mx = fmaxf(fmaxf(fmaxf(x[0], x[1]), fmaxf(x[2], x[3])), fmaxf(fmaxf(x[4], x[5]), fmaxf(x[6], x[7])));
        if (__all(mx <= mrun - 150.0f)) { spec = false; continue; }
        if (!near) SA_LOADV(t);
        mx = fmaxf(mx, __shfl_xor(mx, 16)); mx = fmaxf(mx, __shfl_xor(mx, 32));
        const float mn = fmaxf(mrun, mx), alpha = __builtin_amdgcn_exp2f(mrun - mn); mrun = mn;
        float ps = 0.f;
#pragma unroll
        for (int i = 0; i < 8; ++i) { x[i] = __builtin_amdgcn_exp2f(x[i] - mn); ps += x[i]; }
        lrun = lrun * alpha + ps;
        v4u pw; pw.x = pk2(x[0], x[1]); pw.y = pk2(x[2], x[3]); pw.z = pk2(x[4], x[5]); pw.w = pk2(x[6], x[7]);
        const bf16x8 pf = __builtin_bit_cast(bf16x8, pw);
#pragma unroll
        for (int grp = 0; grp < 2; ++grp)
#pragma unroll
            for (int ii = 0; ii < 4; ++ii) {
                v4u aw; aw.x = pk2(vv[grp][0][ii], vv[grp][1][ii]); aw.y = pk2(vv[grp][2][ii], vv[grp][3][ii]); aw.z = pk2(vv[grp][4][ii], vv[grp][5][ii]); aw.w = pk2(vv[grp][6][ii], vv[grp][7][ii]);
                o[grp][ii] = MFMA16(__builtin_bit_cast(bf16x8, aw), pf, o[grp][ii] * alpha);
            }
    }
#undef SA_LOADK
#undef SA_LOADV
    lrun += __shfl_xor(lrun, 16); lrun += __shfl_xor(lrun, 32);
    LAS float* Wm = (LAS float*)F.lds; LAS float* Wl = Wm + 128; LAS float* WO = (LAS float*)(F.lds + 1024);
    if (g == 0) { Wm[F.wave * 16 + r] = mrun; Wl[F.wave * 16 + r] = lrun; }
#pragma unroll
    for (int grp = 0; grp < 2; ++grp)
#pragma unroll
        for (int i = 0; i < 4; ++i) {
            const f32x4 w = {o[grp][0][i], o[grp][1][i], o[grp][2][i], o[grp][3][i]};
            *(LAS f32x4*)(WO + ((size_t)(F.wave * 16 + r) * FD + 64 * grp + 16 * g + 4 * i)) = w;
        }
    __syncthreads();
    {
        const int q = tid_ >> 5, d0 = (tid_ & 31) * 4;
        float ms = -1e30f;
#pragma unroll
        for (int w = 0; w < NWAVES; ++w) ms = fmaxf(ms, Wm[w * 16 + q]);
        float ls = 0.f; f32x4 acc = {0.f, 0.f, 0.f, 0.f};
#pragma unroll
        for (int w = 0; w < NWAVES; ++w) { const float sc = __builtin_amdgcn_exp2f(Wm[w * 16 + q] - ms); ls += Wl[w * 16 + q] * sc; acc += *(const LAS f32x4*)(WO + (size_t)(w * 16 + q) * FD + d0) * sc; }
        const float inv = 1.0f / ls;
        v2u ov; ov.x = pk2(acc[0] * inv, acc[1] * inv); ov.y = pk2(acc[2] * inv, acc[3] * inv);
        *(v2u*)((hbf*)(F.ws + WS_OA) + (size_t)(MP + bb * DSEQ + q) * FW + h * FD + d0) = ov;
    }
    __syncthreads();
}

constexpr int SGU_PT = 136;
__device__ __forceinline__ void sgu_prompt_unit(const Frame& F, int unit) {
    int tid_ = threadIdx.x; asm volatile("" : "+v"(tid_)); const int lane_ = tid_ & 63;
    const int g = unit & 7, bn = unit >> 3, tok0 = bn * SGC;
    LAS hbf* VtT = (LAS hbf*)F.lds;
    const hbf* VS = (const hbf*)(F.ws + WS_VS); const hbf* US = (const hbf*)(F.ws + WS_US); hbf* OB = (hbf*)(F.ws + WS_OB);
    {
        const int j = tid_ >> 2, pp = tid_ & 3, c0 = 32 * pp;
        const f32x4 q = *(const f32x4*)((const float*)(F.ws + WS_VSSQ) + (size_t)(tok0 + j) * 16 + 4 * pp);
        float t = (q[0] + q[1]) + (q[2] + q[3]); t += __shfl_xor(t, 1); t += __shfl_xor(t, 2);
        const float r_ = 1.0f / sqrtf(t * (1.0f / SGW) + EPS);
        const hbf* src = VS + (size_t)(tok0 + j) * SGW + g * SGC + c0; const float* gsrc = F.in[10] + g * SGC + c0;
#pragma unroll
        for (int k = 0; k < 4; ++k) {
            const v4u raw = *(const v4u*)(src + 8 * k); const f32x4 g0 = *(const f32x4*)(gsrc + 8 * k), g1 = *(const f32x4*)(gsrc + 8 * k + 4);
            const float v[8] = {bflo(raw.x) * r_ * g0[0], bfhi(raw.x) * r_ * g0[1], bflo(raw.y) * r_ * g0[2], bfhi(raw.y) * r_ * g0[3],
                                bflo(raw.z) * r_ * g1[0], bfhi(raw.z) * r_ * g1[1], bflo(raw.w) * r_ * g1[2], bfhi(raw.w) * r_ * g1[3]};
#pragma unroll
            for (int e = 0; e < 8; e += 2) { const unsigned pk = pk2(v[e], v[e + 1]); VtT[(c0 + 8 * k + e) * SGU_PT + j] = (hbf)(pk & 0xffffu); VtT[(c0 + 8 * k + e + 1) * SGU_PT + j] = (hbf)(pk >> 16); }
        }
    }
    __syncthreads();
    const int r = lane_ & 15, q4 = lane_ >> 4, w = F.wave;
    const hbf* Wg = (const hbf*)(F.ws + WS_WSP) + (size_t)g * SGC * SGC;
#pragma unroll
    for (int half = 0; half < 2; ++half) {
        const int iw = half == 0 ? w : 7 - w, cb0 = 4 * half;
        const int nks = (16 * iw + 15) / 32 + 1;
        const int tok = tok0 + 16 * iw + r; const float bsv = F.in[12][g * SGC + 16 * iw + r];
        v2u uu[4];
#pragma unroll
        for (int cb = 0; cb < 4; ++cb) uu[cb] = *(const v2u*)(US + (size_t)tok * SGW + g * SGC + 16 * (cb0 + cb) + 4 * q4);
        f32x4 acc[4];
#pragma unroll
        for (int cb = 0; cb < 4; ++cb) acc[cb] = (f32x4){0.f, 0.f, 0.f, 0.f};
        for (int s_ = 0; s_ < nks; ++s_) {
            const bf16x8 bw = *(const bf16x8*)(Wg + (size_t)(16 * iw + r) * SGC + 32 * s_ + 8 * q4);
#pragma unroll
            for (int cb = 0; cb < 4; ++cb) {
                const bf16x8 av = *(const LAS bf16x8*)(VtT + (16 * (cb0 + cb) + r) * SGU_PT + 32 * s_ + 8 * q4);
                acc[cb] = MFMA16(av, bw, acc[cb]);
            }
        }
#pragma unroll
        for (int cb = 0; cb < 4; ++cb) {
            const size_t off = (size_t)tok * SGW + g * SGC + 16 * (cb0 + cb) + 4 * q4;
            v2u ov; ov.x = pk2(bflo(uu[cb].x) * (acc[cb][0] + bsv), bfhi(uu[cb].x) * (acc[cb][1] + bsv)); ov.y = pk2(bflo(uu[cb].y) * (acc[cb][2] + bsv), bfhi(uu[cb].y) * (acc[cb][3] + bsv));
            *(v2u*)(OB + off) = ov;
        }
    }
    __syncthreads();
}
__device__ __forceinline__ void sgu_sample_unit(const Frame& F, int u) {
    int tid_ = threadIdx.x; asm volatile("" : "+v"(tid_));
    LAS float* rs = (LAS float*)F.lds;
    const hbf* VS = (const hbf*)(F.ws + WS_VS); const hbf* US = (const hbf*)(F.ws + WS_US); hbf* OB = (hbf*)(F.ws + WS_OB);
    const int bb = u >> 3, g = u & 7, tok0 = MP + bb * DSEQ;
    if (tid_ < DSEQ) { const f32x4* p = (const f32x4*)((const float*)(F.ws + WS_VSSQ) + (size_t)(tok0 + tid_) * 16); float t = 0.f;
#pragma unroll
        for (int k = 0; k < 4; ++k) { const f32x4 q = p[k]; t += (q[0] + q[1]) + (q[2] + q[3]); }
        rs[tid_] = 1.0f / sqrtf(t * (1.0f / SGW) + EPS); }
    __syncthreads();
    const int c = g * SGC + (tid_ & 127), iq = __builtin_amdgcn_readfirstlane(tid_ >> 7);
    const float gain = F.in[10][c];
    float vn[DSEQ];
#pragma unroll
    for (int j = 0; j < DSEQ; ++j) vn[j] = __uint_as_float((unsigned)VS[(size_t)(tok0 + j) * SGW + c] << 16) * rs[j] * gain;
#pragma unroll
    for (int k = 0; k < 4; ++k) {
        const int i = iq + 4 * k;
        const float* wr = F.in[11] + ((size_t)g * SGC + i) * SGC;
        float mix = F.in[12][g * SGC + i], vi = 0.f;
#pragma unroll
        for (int j = 0; j < DSEQ; ++j) { const float wj = j <= i ? wr[j] : 0.f; mix += wj * vn[j]; vi = j == i ? vn[j] : vi; }
        const float uu = __uint_as_float((unsigned)US[(size_t)(tok0 + i) * SGW + c] << 16);
        OB[(size_t)(tok0 + i) * SGW + c] = (hbf)(pk2(uu * mix, 0.f) & 0xffffu);
        F.out[O_SGV + (size_t)(bb * DSEQ + i) * SGW + c] = vi;
    }
    __syncthreads();
}
#define CE_D(a, b) { const float h_ = fmaxf(a, b); b = fminf(a, b); a = h_; }
__device__ __forceinline__ void sort16_desc(float (&v)[16]) {
    CE_D(v[0], v[1])
    CE_D(v[3], v[2])
    CE_D(v[4], v[5])
    CE_D(v[7], v[6])
    CE_D(v[8], v[9])
    CE_D(v[11], v[10])
    CE_D(v[12], v[13])
    CE_D(v[15], v[14])
    CE_D(v[0], v[2])
    CE_D(v[1], v[3])
    CE_D(v[6], v[4])
    CE_D(v[7], v[5])
    CE_D(v[8], v[10])
    CE_D(v[9], v[11])
    CE_D(v[14], v[12])
    CE_D(v[15], v[13])
    CE_D(v[0], v[1])
    CE_D(v[2], v[3])
    CE_D(v[5], v[4])
    CE_D(v[7], v[6])
    CE_D(v[8], v[9])
    CE_D(v[10], v[11])
    CE_D(v[13], v[12])
    CE_D(v[15], v[14])
    CE_D(v[0], v[4])
    CE_D(v[1], v[5])
    CE_D(v[2], v[6])
    CE_D(v[3], v[7])
    CE_D(v[12], v[8])
    CE_D(v[13], v[9])
    CE_D(v[14], v[10])
    CE_D(v[15], v[11])
    CE_D(v[0], v[2])
    CE_D(v[1], v[3])
    CE_D(v[4], v[6])
    CE_D(v[5], v[7])
    CE_D(v[10], v[8])
    CE_D(v[11], v[9])
    CE_D(v[14], v[12])
    CE_D(v[15], v[13])
    CE_D(v[0], v[1])
    CE_D(v[2], v[3])
    CE_D(v[4], v[5])
    CE_D(v[6], v[7])
    CE_D(v[9], v[8])
    CE_D(v[11], v[10])
    CE_D(v[13], v[12])
    CE_D(v[15], v[14])
    CE_D(v[0], v[8])
    CE_D(v[1], v[9])
    CE_D(v[2], v[10])
    CE_D(v[3], v[11])
    CE_D(v[4], v[12])
    CE_D(v[5], v[13])
    CE_D(v[6], v[14])
    CE_D(v[7], v[15])
    CE_D(v[0], v[4])
    CE_D(v[1], v[5])
    CE_D(v[2], v[6])
    CE_D(v[3], v[7])
    CE_D(v[8], v[12])
    CE_D(v[9], v[13])
    CE_D(v[10], v[14])
    CE_D(v[11], v[15])
    CE_D(v[0], v[2])
    CE_D(v[1], v[3])
    CE_D(v[4], v[6])
    CE_D(v[5], v[7])
    CE_D(v[8], v[10])
    CE_D(v[9], v[11])
    CE_D(v[12], v[14])
    CE_D(v[13], v[15])
    CE_D(v[0], v[1])
    CE_D(v[2], v[3])
    CE_D(v[4], v[5])
    CE_D(v[6], v[7])
    CE_D(v[8], v[9])
    CE_D(v[10], v[11])
    CE_D(v[12], v[13])
    CE_D(v[14], v[15])
}
__device__ __forceinline__ void merge_top16(float (&a)[16], const float (&b)[16]) {
#pragma unroll
    for (int i = 0; i < 16; ++i) a[i] = fmaxf(a[i], b[15 - i]);
    CE_D(a[0], a[8])
    CE_D(a[1], a[9])
    CE_D(a[2], a[10])
    CE_D(a[3], a[11])
    CE_D(a[4], a[12])
    CE_D(a[5], a[13])
    CE_D(a[6], a[14])
    CE_D(a[7], a[15])
    CE_D(a[0], a[4])
    CE_D(a[1], a[5])
    CE_D(a[2], a[6])
    CE_D(a[3], a[7])
    CE_D(a[8], a[12])
    CE_D(a[9], a[13])
    CE_D(a[10], a[14])
    CE_D(a[11], a[15])
    CE_D(a[0], a[2])
    CE_D(a[1], a[3])
    CE_D(a[4], a[6])
    CE_D(a[5], a[7])
    CE_D(a[8], a[10])
    CE_D(a[9], a[11])
    CE_D(a[12], a[14])
    CE_D(a[13], a[15])
    CE_D(a[0], a[1])
    CE_D(a[2], a[3])
    CE_D(a[4], a[5])
    CE_D(a[6], a[7])
    CE_D(a[8], a[9])
    CE_D(a[10], a[11])
    CE_D(a[12], a[13])
    CE_D(a[14], a[15])
}
__device__ __forceinline__ void ins16(float (&T)[16], float x) {
#pragma unroll
    for (int t = 0; t < 16; ++t) { const float hi_ = fmaxf(T[t], x); x = fminf(T[t], x); T[t] = hi_; }
}
constexpr int PK_PT = 136;
__device__ __forceinline__ void peer_half_top16(const hbf* qrow, const LAS hbf* keys, int r32, int hi, float (&T)[16]) {
    bf16x8 qf[8];
#pragma unroll
    for (int ks = 0; ks < 8; ++ks) qf[ks] = *(const bf16x8*)(qrow + ks * 16 + hi * 8);
    bf16x8 ka[8], kn[8];
#pragma unroll
    for (int ks = 0; ks < 8; ++ks) ka[ks] = *(const LAS bf16x8*)(keys + r32 * PK_PT + ks * 16 + hi * 8);
#pragma unroll 1
    for (int kb = 0; kb < 4; ++kb) {
        const int kbn = kb < 3 ? kb + 1 : 3;
#pragma unroll
        for (int ks = 0; ks < 8; ++ks) kn[ks] = *(const LAS bf16x8*)(keys + (kbn * 32 + r32) * PK_PT + ks * 16 + hi * 8);
        f32x16 acc;
#pragma unroll
        for (int i = 0; i < 16; ++i) acc[i] = 0.f;
#pragma unroll
        for (int ks = 0; ks < 8; ++ks) acc = MFMA32(ka[ks], qf[ks], acc);
        float g[16];
#pragma unroll
        for (int i = 0; i < 16; ++i) { const int key = kb * 32 + (i & 3) + 8 * (i >> 2) + 4 * hi; g[i] = __uint_as_float((__float_as_uint(acc[i]) & ~127u) | (unsigned)key); }
        sort16_desc(g);
        if (kb == 0) {
#pragma unroll
            for (int t = 0; t < 16; ++t) T[t] = g[t];
        } else merge_top16(T, g);
#pragma unroll
        for (int ks = 0; ks < 8; ++ks) ka[ks] = kn[ks];
    }
    float oth[16];
#pragma unroll
    for (int t = 0; t < 16; ++t) oth[t] = __shfl_xor(T[t], 32);
    merge_top16(T, oth);
}
__device__ __forceinline__ void peer_topk_unit(const Frame& F, int unit) {
    const int pm = unit >> 3, h = unit & 7, r32 = F.lane & 31, hi = F.lane >> 5;
    const int tok = pm * 256 + F.wave * 32 + r32;
    const hbf* qrow = (const hbf*)(F.ws + WS_QN) + (size_t)tok * DM + h * PED;
    const hbf* sk = (const hbf*)(F.ws + WS_SK) + (size_t)h * 2 * PEK * 128;
    LAS hbf* KL = (LAS hbf*)F.lds;
    __syncthreads();
    for (int i = F.tid; i < 2 * PEK * 16; i += NTHREADS) { const int row = i >> 4, c = i & 15; *(LAS v4u*)(KL + row * PK_PT + c * 8) = *(const v4u*)(sk + (size_t)row * 128 + c * 8); }
    __syncthreads();
    float A[16], B[16];
    peer_half_top16(qrow, KL, r32, hi, A);
    peer_half_top16(qrow + 128, KL + PEK * PK_PT, r32, hi, B);
#define CAND(a, b) __uint_as_float((__float_as_uint(__uint_as_float(__float_as_uint(A[a]) & ~127u) + __uint_as_float(__float_as_uint(B[b]) & ~127u)) & ~255u) | (unsigned)((a) * 16 + (b)))
    float C[16], M[16];
#pragma unroll
    for (int b = 0; b < 16; ++b) C[b] = CAND(0, b);
#pragma unroll
    for (int b = 0; b < 8; ++b) { M[b] = CAND(1, b); M[8 + b] = CAND(15 - b, 0); }
    CE_D(M[0], M[8]) CE_D(M[1], M[9]) CE_D(M[2], M[10]) CE_D(M[3], M[11]) CE_D(M[4], M[12]) CE_D(M[5], M[13]) CE_D(M[6], M[14]) CE_D(M[7], M[15])
    CE_D(M[0], M[4]) CE_D(M[1], M[5]) CE_D(M[2], M[6]) CE_D(M[3], M[7]) CE_D(M[8], M[12]) CE_D(M[9], M[13]) CE_D(M[10], M[14]) CE_D(M[11], M[15])
    CE_D(M[0], M[2]) CE_D(M[1], M[3]) CE_D(M[4], M[6]) CE_D(M[5], M[7]) CE_D(M[8], M[10]) CE_D(M[9], M[11]) CE_D(M[12], M[14]) CE_D(M[13], M[15])
    CE_D(M[0], M[1]) CE_D(M[2], M[3]) CE_D(M[4], M[5]) CE_D(M[6], M[7]) CE_D(M[8], M[9]) CE_D(M[10], M[11]) CE_D(M[12], M[13]) CE_D(M[14], M[15])
    merge_top16(C, M);
    M[0] = CAND(2, 0); M[1] = CAND(2, 1); M[2] = CAND(2, 2); M[3] = CAND(2, 3); M[4] = CAND(2, 4); M[5] = CAND(3, 0); M[6] = CAND(3, 1); M[7] = CAND(3, 2); M[8] = CAND(3, 3);
    M[9] = CAND(4, 0); M[10] = CAND(4, 1); M[11] = CAND(4, 2); M[12] = CAND(5, 0); M[13] = CAND(5, 1); M[14] = CAND(6, 0); M[15] = CAND(6, 1);
    sort16_desc(M);
    merge_top16(C, M);
    ins16(C, CAND(7, 0)); ins16(C, CAND(7, 1));
#undef CAND
    float e[16], sum = 0.f; const float c0 = __uint_as_float(__float_as_uint(C[0]) & ~255u);
#pragma unroll
    for (int t = 0; t < 16; ++t) { e[t] = __builtin_amdgcn_exp2f((__uint_as_float(__float_as_uint(C[t]) & ~255u) - c0) * LOG2E); sum += e[t]; }
    const float inv = 1.0f / sum;
    unsigned pa[4], pb[4];
#pragma unroll
    for (int w = 0; w < 4; ++w) {
        pa[w] = (__float_as_uint(A[4 * w]) & 127u) | ((__float_as_uint(A[4 * w + 1]) & 127u) << 8) | ((__float_as_uint(A[4 * w + 2]) & 127u) << 16) | ((__float_as_uint(A[4 * w + 3]) & 127u) << 24);
        pb[w] = (__float_as_uint(B[4 * w]) & 127u) | ((__float_as_uint(B[4 * w + 1]) & 127u) << 8) | ((__float_as_uint(B[4 * w + 2]) & 127u) << 16) | ((__float_as_uint(B[4 * w + 3]) & 127u) << 24);
    }
    int ei[16];
#pragma unroll
    for (int t = 0; t < 16; ++t) {
        const unsigned code = __float_as_uint(C[t]) & 255u, ca = code >> 4, cb = code & 15u;
        const unsigned wa = (ca >> 2) == 0 ? pa[0] : (ca >> 2) == 1 ? pa[1] : (ca >> 2) == 2 ? pa[2] : pa[3];
        const unsigned wb = (cb >> 2) == 0 ? pb[0] : (cb >> 2) == 1 ? pb[1] : (cb >> 2) == 2 ? pb[2] : pb[3];
        const unsigned i1 = (wa >> ((ca & 3u) * 8u)) & 127u, i2 = (wb >> ((cb & 3u) * 8u)) & 127u;
        ei[t] = (int)(i1 * PEK + i2); e[t] *= inv;
    }
    if (hi == 0) {
        int* eo = (int*)(F.ws + WS_EI) + ((size_t)tok * PEH + h) * 16; float* go = (float*)(F.ws + WS_GW) + ((size_t)tok * PEH + h) * 16;
#pragma unroll
        for (int t = 0; t < 16; t += 4) { *(int4*)(eo + t) = make_int4(ei[t], ei[t + 1], ei[t + 2], ei[t + 3]); *(f32x4*)(go + t) = (f32x4){e[t], e[t + 1], e[t + 2], e[t + 3]}; }
    }
}

typedef float f32x2_ __attribute__((ext_vector_type(2)));
typedef int v8i_ __attribute__((ext_vector_type(8)));
constexpr float PEER_SU = 64.f, PEER_SV = 16.f;
__device__ __forceinline__ void peer_gather_token_x(const Frame& F0, int tok, const bool SPLIT) {
    Frame F = F0; { int t_ = threadIdx.x; asm volatile("" : "+v"(t_)); F.tid = t_; F.lane = t_ & 63; }
    const unsigned char* TU = (const unsigned char*)(F.ws + WS_TU); const unsigned char* TV = (const unsigned char*)(F.ws + WS_TV);
    const int r16 = F.lane & 15, q4 = F.lane >> 4;
    LAS unsigned char* xl = F.lds + F.wave * DM;
    {
        const hbf* xg = (const hbf*)(F.ws + WS_XG) + (size_t)tok * DM + 32 * F.lane; const float* gf = F.in[16] + 32 * F.lane;
        v4u o[2];
#pragma unroll
        for (int c = 0; c < 4; ++c) { const v4u w = *(const v4u*)(xg + 8 * c); const f32x4 ga = *(const f32x4*)(gf + 8 * c), gb = *(const f32x4*)(gf + 8 * c + 4);
            int p0 = 0, p1 = 0;
            p0 = __builtin_amdgcn_cvt_pk_fp8_f32(bflo(w.x) * ga[0], bfhi(w.x) * ga[1], p0, false); p0 = __builtin_amdgcn_cvt_pk_fp8_f32(bflo(w.y) * ga[2], bfhi(w.y) * ga[3], p0, true);
            p1 = __builtin_amdgcn_cvt_pk_fp8_f32(bflo(w.z) * gb[0], bfhi(w.z) * gb[1], p1, false); p1 = __builtin_amdgcn_cvt_pk_fp8_f32(bflo(w.w) * gb[2], bfhi(w.w) * gb[3], p1, true);
            o[c >> 1][2 * (c & 1)] = (unsigned)p0; o[c >> 1][2 * (c & 1) + 1] = (unsigned)p1; }
        *(LAS v4u*)(xl + 32 * F.lane) = o[0]; *(LAS v4u*)(xl + 32 * F.lane + 16) = o[1];
    }
    float t = (F.lane < 32) ? ((const float*)(F.ws + WS_XSSQ))[(size_t)tok * 32 + F.lane] : 0.f;
    const float rstd = (1.0f / PEER_SU) / sqrtf(wave_sum_dpp(t) * (1.0f / DM) + EPS);
    const int* ei = (const int*)(F.ws + WS_EI) + (size_t)tok * 128; const float* gw = (const float*)(F.ws + WS_GW) + (size_t)tok * 128;
#ifdef PROBE_P7MASK
    const int pm_ = F0.probe ? PROBE_P7MASK : 0xffffff; const int e0 = ei[F.lane] & pm_, e1 = ei[64 + F.lane] & pm_;
#else
    const int e0 = ei[F.lane], e1 = ei[64 + F.lane];
#endif
    const float g0 = gw[F.lane] * (1.0f / PEER_SV), g1 = gw[64 + F.lane] * (1.0f / PEER_SV);
    f32x2_ acc2[16];
#pragma unroll
    for (int i = 0; i < 16; ++i) acc2[i] = (f32x2_){0.f, 0.f};
    asm volatile("s_waitcnt lgkmcnt(0)" ::: "memory");
#define FP4_ACC(V, k, bsel) { const f32x2_ p = __builtin_amdgcn_cvt_scalef32_pk_f32_fp4(V[k], 1.0f, bsel); acc2[4 * (k) + (bsel)] = __builtin_elementwise_fma(p, w2, acc2[4 * (k) + (bsel)]); }
#define PG_ACC(V, m0) do { _Pragma("unroll") for (int m = 0; m < 8; ++m) { \
        const float wm = __builtin_bit_cast(float, __builtin_amdgcn_readlane(__builtin_bit_cast(int, wl), (m0) + m)); const f32x2_ w2 = {wm, wm}; \
        _Pragma("unroll") for (int k = 0; k < 4; ++k) { FP4_ACC(V[m], k, 0) FP4_ACC(V[m], k, 1) FP4_ACC(V[m], k, 2) FP4_ACC(V[m], k, 3) } } } while (0)
#pragma unroll 1
    for (int b = SPLIT ? F.wave : 0; b < (SPLIT ? F.wave + 1 : 8); ++b) {
        const int esrc = b < 4 ? e0 : e1; const float gsrc = b < 4 ? g0 : g1; const int lb = 16 * (b & 3);
        const int erA = __shfl(esrc, lb + (r16 & 7)), erB = __shfl(esrc, lb + 8 + (r16 & 7));
        v4u ua[16], vr[8], vs[8];
        const unsigned char* upA = TU + (size_t)erA * (DM / 2) + 64 * (r16 >> 3) + 16 * q4; const unsigned char* upB = TU + (size_t)erB * (DM / 2) + 64 * (r16 >> 3) + 16 * q4;
#pragma unroll
        for (int j = 0; j < 8; ++j) { ua[j] = *(const v4u*)(upA + 128 * j); ua[8 + j] = *(const v4u*)(upB + 128 * j); }
#pragma unroll
        for (int m = 0; m < 8; ++m) { const int e = __builtin_amdgcn_readlane(esrc, lb + m); vr[m] = *(const v4u*)(TV + (size_t)e * (DM / 2) + 16 * F.lane); }
        f32x4 z0 = {0.f, 0.f, 0.f, 0.f}, z1 = {0.f, 0.f, 0.f, 0.f};
        const LAS unsigned char* xa = xl + (r16 == 1 ? 128 : 0) + 16 * q4;
#pragma unroll
        for (int j = 0; j < 8; ++j) {
            const v4u x0 = *(const LAS v4u*)(xa + 256 * j), x1 = *(const LAS v4u*)(xa + 256 * j + 64);
            const v8i_ Ax = {(int)x0.x, (int)x0.y, (int)x0.z, (int)x0.w, (int)x1.x, (int)x1.y, (int)x1.z, (int)x1.w};
            const v8i_ Ba = {(int)ua[j].x, (int)ua[j].y, (int)ua[j].z, (int)ua[j].w, 0, 0, 0, 0}, Bb = {(int)ua[8 + j].x, (int)ua[8 + j].y, (int)ua[8 + j].z, (int)ua[8 + j].w, 0, 0, 0, 0};
            z0 = __builtin_amdgcn_mfma_scale_f32_16x16x128_f8f6f4(Ax, Ba, z0, 0  , 4  , 0, 0x7f7f7f7f, 0, 0x7f7f7f7f);
            z1 = __builtin_amdgcn_mfma_scale_f32_16x16x128_f8f6f4(Ax, Bb, z1, 0, 4, 0, 0x7f7f7f7f, 0, 0x7f7f7f7f);
            if ((j & 1) == 1) __builtin_amdgcn_sched_barrier(0);
        }
#pragma unroll
        for (int m = 0; m < 8; ++m) { const int e = __builtin_amdgcn_readlane(esrc, lb + 8 + m); vs[m] = *(const v4u*)(TV + (size_t)e * (DM / 2) + 16 * F.lane); }
        const int n7 = r16 & 7;
        const float za = __shfl(z0[0], n7) + __shfl(z0[1], n7 + 8), zb = __shfl(z1[0], n7) + __shfl(z1[1], n7 + 8);
        const float wl = __shfl(gsrc, lb + r16) * gelu_tanh((r16 < 8 ? za : zb) * rstd);
#ifdef PROBE_P7NOACC
        if (F0.probe) { unsigned xx = 0;
#pragma unroll
            for (int m = 0; m < 8; ++m) xx ^= (vr[m].x ^ vr[m].y ^ vr[m].z ^ vr[m].w) ^ (vs[m].x ^ vs[m].y ^ vs[m].z ^ vs[m].w);
            acc2[0].x += __uint_as_float(xx & 0xff) * wl; }
        else
#endif
        { PG_ACC(vr, 0);
        PG_ACC(vs, 8); }
    }
#undef PG_ACC
#undef FP4_ACC
    if (SPLIT) {
        LAS float* pbase = (LAS float*)(F.lds + 32768);
        LAS float* part = pbase + F.wave * DM + 32 * F.lane;
#pragma unroll
        for (int k = 0; k < 8; ++k) *(LAS f32x4*)(part + 4 * k) = (f32x4){acc2[2 * k].x, acc2[2 * k].y, acc2[2 * k + 1].x, acc2[2 * k + 1].y};
        __syncthreads();
        const int c0 = 4 * F.tid;
        f32x4 sacc = {0.f, 0.f, 0.f, 0.f};
#pragma unroll
        for (int w = 0; w < NWAVES; ++w) sacc += *(const LAS f32x4*)(pbase + w * DM + c0);
        const v2u xb = *(const v2u*)((const hbf*)(F.ws + WS_XG) + (size_t)tok * DM + c0);
        sacc += (f32x4){bflo(xb.x), bfhi(xb.x), bflo(xb.y), bfhi(xb.y)};
        *(f32x4*)(F.out + O_Y + (size_t)tok * DM + c0) = sacc;
        __syncthreads();
        return;
    }
#ifdef PROBE_P7MASK
    float* orow = (F0.probe ? (float*)(F.ws + WS_H) : F.out + O_Y) + (size_t)tok * DM + 32 * F.lane;
#else
    float* orow = F.out + O_Y + (size_t)tok * DM + 32 * F.lane;
#endif
    const hbf* xrow1 = (const hbf*)(F.ws + WS_XG) + (size_t)tok * DM + 32 * F.lane;
#pragma unroll
    for (int k = 0; k < 4; ++k) { const v4u w = *(const v4u*)(xrow1 + 8 * k);
        const f32x4 a = (f32x4){bflo(w.x), bfhi(w.x), bflo(w.y), bfhi(w.y)} + (f32x4){acc2[4 * k].x, acc2[4 * k].y, acc2[4 * k + 1].x, acc2[4 * k + 1].y};
        const f32x4 b = (f32x4){bflo(w.z), bfhi(w.z), bflo(w.w), bfhi(w.w)} + (f32x4){acc2[4 * k + 2].x, acc2[4 * k + 2].y, acc2[4 * k + 3].x, acc2[4 * k + 3].y};
        *(f32x4*)(orow + 8 * k) = a; *(f32x4*)(orow + 8 * k + 4) = b; }
}
#ifndef MK_LAUNCHES
#define MK_LAUNCHES 1
#endif
constexpr int NPHASE = 8;
struct Args { const float* in[22]; float* out; unsigned char* ws; int ph_lo, ph_hi, attn_w, attn_skv, q_lo, q_hi; };

__global__ void __launch_bounds__(NTHREADS, 2) fox_sgu_peer_fwd(Args args) {
    extern __shared__ __attribute__((aligned(16))) unsigned char lds[];
#define MKFRAME() Frame F; { int t_ = threadIdx.x; asm volatile("" : "+v"(t_)); F.lds = (LAS unsigned char*)lds; F.lds_g = lds; F.tid = t_; F.lane = t_ & 63; F.wave = __builtin_amdgcn_readfirstlane(t_ >> 6); \
        F.G = gridDim.x; F.probe = args.q_lo == 999; const int bx_ = blockIdx.x; F.vcu = (F.G % 8 == 0) ? (bx_ % 8) * (F.G / 8) + bx_ / 8 : bx_; F.in = args.in; unsigned long long w_ = (unsigned long long)args.ws, o_ = (unsigned long long)args.out; asm volatile("" : "+s"(w_), "+s"(o_)); F.out = (float*)(GAS float*)o_; F.ws = (unsigned char*)(GAS unsigned char*)w_; } \
        unsigned char* ws = F.ws; LAS float* stat = (LAS float*)(F.lds + LDS_STAT); (void)stat; (void)ws
    const int lo = args.ph_lo, hi = args.ph_hi;
#ifndef PH_MASK
#define PH_MASK 0xff
#endif
#define IN(k) (((PH_MASK >> (k)) & 1) && lo <= (k) && (k) < hi)
#if MK_LAUNCHES == 1
    volatile LAS unsigned* xb_st = (volatile LAS unsigned*)((LAS unsigned char*)lds + LDS_XB);
    if (threadIdx.x == 0) { xb_st[0] = 0u; xb_st[1] = 0u; xb_st[3] = blockIdx.x; }
    __syncthreads();
    (void)xcd_barrier_post((unsigned*)(args.ws + WS_CTL) + CW_BAR, xb_st);
#define XBAR() do { XcdBarrier bar_; bar_.bar = (unsigned*)(args.ws + WS_CTL) + CW_BAR; bar_.x = xb_xcc_id(); bar_.st = xb_st; xcd_barrier(bar_); } while (0)
#define SEAM(k) do { if (IN(k) && IN((k) + 1)) XBAR(); } while (0)
#else
#define XBAR() do { } while (0)
#define SEAM(k) do { } while (0)
#endif
#ifndef PROBE_REP
#define PROBE_REP (-1)
#endif
#define REPS(k) for (int rep_ = 0; rep_ < ((PROBE_REP == (k)) ? 2 : 1); ++rep_)

    if (lo < 0) cooperative_groups::this_grid().sync();
    if (IN(0)) REPS(0) { if (rep_) XBAR(); MKFRAME(); phase0(F); __syncthreads(); }
    SEAM(0);
#if MK_LAUNCHES == 1
    if (IN(0) && IN(1)) {
        if (threadIdx.x == 0 && gridDim.x == 256) { unsigned* bar_ = (unsigned*)(args.ws + WS_CTL) + CW_BAR; bool ok_ = true;
            for (unsigned j = 0; j < 8; ++j) ok_ = ok_ && (xb_ld(&bar_[XB_XCNT(j)]) == 32u);
            const unsigned x_ = xb_xcc_id();
            if (ok_ && x_ < 8u && xb_st[2] < 32u) xb_st[3] = xb_st[2] * 8u + x_; }
        __syncthreads();
    }
#endif
#define VB() ((int)__builtin_amdgcn_readfirstlane((int)xb_st[3]))
    if (IN(1)) REPS(1) {
        if (rep_) XBAR();
        MKFRAME();
        for (int u = blockIdx.x; u < NBATCH + DBATCH; u += F.G) phase1_scan(F, u);
#ifndef P1_SKEW_NUM
#define P1_SKEW_NUM 0
#endif
#ifndef P1_SKEW_GROUPS
#define P1_SKEW_GROUPS 2
#endif
        constexpr size_t CV_ALL = (size_t)NEXP * DM / 32, CV_UNIT = CV_ALL * P1_SKEW_NUM / 100 / 512 * 512;
        constexpr int SKG = 4;
        const bool skew = F.G == 256 && P1_SKEW_NUM > 0;
        const int vb1 = VB();
        if (P0_LATE_OK(F) && (vb1 & 4) && vb1 >= 40) { late_weights(F, (LAS float*)(F.lds + F.wave * 8448), (int)((((vb1 - 40) >> 3) << 2) | (vb1 & 3)) * NWAVES + F.wave, 108 * NWAVES); __syncthreads(); }
        if (skew && blockIdx.x >= 40) { const int xcd = blockIdx.x & 7, g = xcd & 3;
            if (g) convert_tables(F, (int)((((blockIdx.x - 40) >> 3) << 1) | (xcd >> 2)), 54, CV_UNIT * (size_t)(g * (g - 1) / 2), CV_UNIT * (size_t)(g * (g + 1) / 2)); }
        const size_t cv_lo = skew ? CV_UNIT * (size_t)(SKG * (SKG - 1) / 2) : 0;
        pg8::Gemm g{(const pg8::bf16_t*)(ws + WS_H), (const pg8::bf16_t*)(ws + WS_WIN), MT, NZ, DM};
        pg8::StaticOrder S; S.init(MT, NZ, F.G, vb1);
        EpiIn E{(hbf*)(ws + WS_Q), (hbf*)(ws + WS_QS), (hbf*)(ws + WS_K), (hbf*)(ws + WS_V), (hbf*)(ws + WS_US), (hbf*)(ws + WS_VS), (hbf*)(ws + WS_GA), (hbf*)(ws + WS_GB),
                F.out, (float*)(ws + WS_VSSQ), F.in[8], F.in[9], stat, args.q_lo == 777 ? 1 : 0};
        pg8::gemm_phase<EpiIn, pg8::StaticOrder, true, true>(F.lds, g, S, E);
        __syncthreads();
        { const int nlast = (MT / 256) * (NZ / 256) % F.G;
#ifdef CV_STATIC
          if (nlast == 0 || nlast * 2 > F.G) convert_tables(F, (int)blockIdx.x, F.G, cv_lo); else if ((int)blockIdx.x >= nlast) convert_tables(F, (int)blockIdx.x - nlast, F.G - nlast, cv_lo); }
#else
          (void)nlast; convert_tables_dyn(F, cv_lo); }
#endif
    }
    SEAM(1);
#ifdef NO_AS
#define AS_CALL(u) do { } while (0)
#else
#define AS_CALL(u) attn_sample_unit(F, u)
#endif
#ifdef NO_SGU
#define SGU_CALL(u) do { } while (0)
#else
#define SGU_CALL(u) do { } while (0)
#endif
    if (IN(2)) REPS(2) {
        if (rep_) XBAR();
        MKFRAME();
        {
            using namespace attn;
            const float thr_raw = attn_skip_threshold(F);
            char* ldsg = (char*)F.lds_g; float* bias_lds = (float*)(ldsg + ATT_BIAS_OFF);
            int item = p2_pop(F);
            const int qlo_ = args.q_lo, qhi_ = args.q_hi;
            while (item < Q_SAMPLE) { if (item >= qlo_ && item < qhi_) attn_sample_unit(F, item); item = p2_pop(F); }
            while (item < Q_SAMPLE + Q_PROMPT) {
                if (item < qlo_ || item >= qhi_) { item = p2_pop(F); continue; }
                const BlockRef<bf16, bf16> cur = attn_prompt_ref(F, item - Q_SAMPLE, thr_raw);
                Seam<bf16> S;
                causal_swa_prime<bf16, bf16>(cur, args.attn_w, ldsg, S);
                causal_swa_block<bf16, bf16>(cur, cur, args.attn_skv, args.attn_w, ldsg, S, bias_lds);
                item = p2_pop(F);
            }
#define P2_POP_AHEAD(CALL) do { unsigned nx_ = 0; if (F.tid == 0) nx_ = atomicAdd((unsigned*)(ws + WS_CTL) + CW_Q, 1u); CALL; \
        LAS int* slot_ = (LAS int*)(F.lds + LDS_POP) + 1; if (F.tid == 0) *slot_ = (int)nx_; __syncthreads(); item = __builtin_amdgcn_readfirstlane(*slot_); __syncthreads(); } while (0)
            while (item < Q_SGP) P2_POP_AHEAD(sgu_sample_unit(F, item - Q_SGS));
            while (item < Q_END) P2_POP_AHEAD(sgu_prompt_unit(F, item - Q_SGP));
#undef P2_POP_AHEAD
        }
    }
    SEAM(2);
    const bool whole = (lo <= 3 && hi >= 8 && ((PH_MASK >> 3) & 0x1f) == 0x1f) && gridDim.x > NCHAIN;
    const int ci = (int)blockIdx.x - ((int)gridDim.x - NCHAIN);
    {
        const int ntm = whole ? (false ? 1 : NTM - 1) : NTM;
#define PSEAM(k) SEAM(k)
        if (IN(3)) {
            MKFRAME();
            pg8::Gemm g{(const pg8::bf16_t*)(ws + WS_OA), (const pg8::bf16_t*)(ws + WS_WAB), 2 * MT, 2 * DM, FW};
            MergeOrder S{false ? NCHAIN : F.G, false ? ci : VB(), false ? (NTM - 1) * 8 : 0, ntm * 8 + (false ? (NTM - 1) * 8 : 0)};
            EpiMerge E{(const hbf*)(ws + WS_GA), (const hbf*)(ws + WS_GB), (hbf*)(ws + WS_Y)};
            pg8::gemm_phase<EpiMerge, MergeOrder, true, true>(F.lds, g, S, E);
            __syncthreads();
        }
        PSEAM(3);
        if (IN(4)) {
            MKFRAME();
            pg8::Gemm g{(const pg8::bf16_t*)(ws + WS_Y), (const pg8::bf16_t*)(ws + WS_WO), MT, DM, DM};
            TileOrder S; S.so.init(ntm * 256, DM, F.G, VB()); S.chain = false; S.ci = ci;
            EpiOut E{F.in[0], F.in[1], (hbf*)(ws + WS_XG), (float*)(ws + WS_XSSQ)};
            pg8::gemm_phase<EpiOut, TileOrder, true, true>(F.lds, g, S, E);
            __syncthreads();
        }
        PSEAM(4);
        if (IN(5)) {
            MKFRAME();
            pg8::Gemm g{(const pg8::bf16_t*)(ws + WS_XG), (const pg8::bf16_t*)(ws + WS_WPQ), MT, DM, DM};
            TileOrder S; S.so.init(ntm * 256, DM, F.G, VB()); S.chain = false; S.ci = ci;
            EpiPeerQ E{(const float*)(ws + WS_XSSQ), F.in[18], (hbf*)(ws + WS_QN), stat};
            pg8::gemm_phase<EpiPeerQ, TileOrder, true, true>(F.lds, g, S, E);
            asm volatile("s_waitcnt vmcnt(0)" ::: "memory"); __syncthreads();
            if (IN(6)) { pg8::Unit u_; for (int i = 0; S.next(i, u_); ++i) peer_topk_unit(F, u_.pm * PEH + u_.pn); }
        }
        else if (IN(6)) { MKFRAME(); for (int u = blockIdx.x; u < ntm * PEH; u += F.G) peer_topk_unit(F, u); }
        PSEAM(6);
#undef PSEAM
    }
    if (whole && ci >= 0) {
        const int ntm = whole ? (true ? 1 : NTM - 1) : NTM;
        unsigned chain_round = 0u;
#define PSEAM(k) do { chain_barrier((unsigned*)(args.ws + WS_CTL) + CW_CHAIN, chain_round); ++chain_round; } while (0)
        if (IN(3)) {
            MKFRAME();
            pg8::Gemm g{(const pg8::bf16_t*)(ws + WS_OA), (const pg8::bf16_t*)(ws + WS_WAB), 2 * MT, 2 * DM, FW};
            MergeOrder S{true ? NCHAIN : F.G, true ? ci : (int)blockIdx.x, true ? (NTM - 1) * 8 : 0, ntm * 8 + (true ? (NTM - 1) * 8 : 0)};
            EpiMerge E{(const hbf*)(ws + WS_GA), (const hbf*)(ws + WS_GB), (hbf*)(ws + WS_Y)};
            pg8::gemm_phase<EpiMerge, MergeOrder, true, true>(F.lds, g, S, E);
            __syncthreads();
        }
        PSEAM(3);
        if (IN(4)) {
            MKFRAME();
            pg8::Gemm g{(const pg8::bf16_t*)(ws + WS_Y), (const pg8::bf16_t*)(ws + WS_WO), MT, DM, DM};
            TileOrder S; S.so.init(ntm * 256, DM, F.G, (int)blockIdx.x); S.chain = true; S.ci = ci;
            EpiOut E{F.in[0], F.in[1], (hbf*)(ws + WS_XG), (float*)(ws + WS_XSSQ)};
            pg8::gemm_phase<EpiOut, TileOrder, true, true>(F.lds, g, S, E);
            __syncthreads();
        }
        PSEAM(4);
        if (IN(5)) {
            MKFRAME();
            pg8::Gemm g{(const pg8::bf16_t*)(ws + WS_XG), (const pg8::bf16_t*)(ws + WS_WPQ), MT, DM, DM};
            TileOrder S; S.so.init(ntm * 256, DM, F.G, (int)blockIdx.x); S.chain = true; S.ci = ci;
            EpiPeerQ E{(const float*)(ws + WS_XSSQ), F.in[18], (hbf*)(ws + WS_QN), stat};
            pg8::gemm_phase<EpiPeerQ, TileOrder, true, true>(F.lds, g, S, E);
            asm volatile("s_waitcnt vmcnt(0)" ::: "memory"); __syncthreads();
            if (IN(6)) peer_topk_unit(F, (NTM - 1) * PEH + ci);
        }
        PSEAM(6);
#undef PSEAM
    }
#ifndef P7_SPLIT_EXTRA
#define P7_SPLIT_EXTRA 0
#endif
    if (IN(7)) {
        MKFRAME();
#ifdef PROBE_MICRO
        if (F.probe) {
            unsigned x = (unsigned)F.tid * 2654435761u + 12345u; unsigned long long w2 = 0x3f8000003f800000ull; unsigned wh = 0x3c003c00u;
            unsigned long long a[16]; unsigned ah[16];
#pragma unroll
            for (int k = 0; k < 16; ++k) { a[k] = 0ull; ah[k] = 0u; }
#pragma unroll 1
            for (int it = 0; it < 4096; ++it) {
#pragma unroll
                for (int k = 0; k < 16; ++k) {
#if PROBE_MICRO == 1
                    unsigned long long p; asm volatile("v_cvt_scalef32_pk_f32_fp4 %0, %1, 1.0" : "=v"(p) : "v"(x)); asm volatile("v_pk_fma_f32 %0, %1, %2, %0" : "+v"(a[k]) : "v"(p), "v"(w2));
#elif PROBE_MICRO == 2
                    unsigned p; asm volatile("v_cvt_scalef32_pk_f16_fp4 %0, %1, 1.0" : "=v"(p) : "v"(x)); asm volatile("v_pk_fma_f16 %0, %1, %2, %0" : "+v"(ah[k]) : "v"(p), "v"(wh));
#elif PROBE_MICRO == 3
                    asm volatile("v_cvt_scalef32_pk_f32_fp4 %0, %1, 1.0" : "=v"(a[k]) : "v"(x));
#else
                    asm volatile("v_pk_fma_f32 %0, %1, %2, %0" : "+v"(a[k]) : "v"(w2), "v"(w2));
#endif
                }
                x = x * 1664525u + 1013904223u;
            }
            unsigned long long t = 0;
#pragma unroll
            for (int k = 0; k < 16; ++k) t += a[k] + ah[k];
            ((unsigned long long*)(ws + WS_H))[(size_t)blockIdx.x * NTHREADS + F.tid] = t;
        } else
#endif
        if (!whole) { const int gw = F.vcu * NWAVES + F.wave, NGW = F.G * NWAVES; for (int tok = gw; tok < MT; tok += NGW) peer_gather_token_x(F, tok, false); }
        else {
            const int NGW = (F.G - NCHAIN) * NWAVES, nfull = MP / NGW - P7_SPLIT_EXTRA;
            const int base = ci < 0 ? (int)blockIdx.x * NWAVES + F.wave : MP + ci * NWAVES + F.wave, step = ci < 0 ? NGW : NCHAIN * NWAVES, nmine = ci < 0 ? nfull : (MT - MP) / (NCHAIN * NWAVES);
            LAS int* slot = (LAS int*)(F.lds + LDS_POP); unsigned* ctr = (unsigned*)(ws + WS_CTL) + CW_P7;
            unsigned nx = 0;
            for (int k = 0; ; ++k) {
                const bool sp = k >= nmine;
                int tk = base + k * step;
                if (sp) { if (F.tid == 0) slot[k & 1] = (int)nx; __syncthreads(); tk = nfull * NGW + __builtin_amdgcn_readfirstlane(slot[k & 1]); if (tk >= MP) break; }
                if (k >= nmine - 1 && F.tid == 0) nx = atomicAdd(ctr, 1u);
                peer_gather_token_x(F, tk, sp);
            } }
    }
#undef IN
#undef SEAM
}

extern "C" void kernel_launch(void* const* d_in, const int* in_sizes, int n_in, void* d_out, int out_size, void* d_ws, size_t ws_size, hipStream_t stream) {
    static int grid = 0;
    if (grid == 0) {
        if (n_in != 22 || out_size != (int)O_END || ws_size < WS_END) { fprintf(stderr, "kernel_launch: unexpected shapes (n_in %d, out %d, ws %zu; need ws >= %zu); nothing launched\n", n_in, out_size, ws_size, (size_t)WS_END); grid = -1; return; }
        int dev = 0, cus = 0, per_cu = 0;
        if (hipGetDevice(&dev) != hipSuccess || hipDeviceGetAttribute(&cus, hipDeviceAttributeMultiprocessorCount, dev) != hipSuccess) { grid = -1; return; }
        if (hipFuncSetAttribute((const void*)fox_sgu_peer_fwd, hipFuncAttributeMaxDynamicSharedMemorySize, LDS_BYTES) != hipSuccess) { fprintf(stderr, "kernel_launch: hipFuncSetAttribute failed\n"); grid = -1; return; }
        if (hipOccupancyMaxActiveBlocksPerMultiprocessor(&per_cu, (const void*)fox_sgu_peer_fwd, NTHREADS, LDS_BYTES) != hipSuccess || per_cu < 1) { fprintf(stderr, "kernel_launch: occupancy query says %d workgroups per CU\n", per_cu); per_cu = 1; }
        (void)hipGetLastError();
        grid = cus * 1;
        if (grid > 256) grid = 256;
    }
    if (grid < 0) return;
#if MK_LAUNCHES == 1
    if (hipMemsetAsync((char*)d_ws + WS_CTL, 0, CTL_ZERO, stream) != hipSuccess) { fprintf(stderr, "kernel_launch: hipMemsetAsync failed\n"); return; }
#endif
    Args a{};
    for (int i = 0; i < 22; ++i) a.in[i] = (const float*)d_in[i];
    a.out = (float*)d_out; a.ws = (unsigned char*)d_ws; a.attn_w = 1 << 30; a.attn_skv = SEQ; a.q_lo = 0; a.q_hi = 1 << 30;
#if MK_LAUNCHES == 1
    a.ph_lo = 0; a.ph_hi = NPHASE;
    void* kargs[] = {&a};
    hipError_t e = hipLaunchCooperativeKernel((const void*)fox_sgu_peer_fwd, dim3(grid), dim3(NTHREADS), kargs, LDS_BYTES, stream);
    if (e != hipSuccess) fprintf(stderr, "kernel_launch: cooperative launch failed: %s (grid %d)\n", hipGetErrorString(e), grid);
#ifdef PROBE_PHASE
    a.ph_lo = PROBE_PHASE; a.ph_hi = PROBE_PHASE + 1;
#ifdef PROBE_QLO
    a.q_lo = PROBE_QLO; a.q_hi = PROBE_QHI;
#endif
    (void)hipMemsetAsync((char*)d_ws + WS_CTL + CW_Q * 4, 0, 256, stream);
    hipLaunchKernelGGL(fox_sgu_peer_fwd, dim3(grid), dim3(NTHREADS), LDS_BYTES, stream, a);
#endif
#else
    for (int p = 0; p < NPHASE; ++p) {
        a.ph_lo = p; a.ph_hi = p + 1;
        hipLaunchKernelGGL(fox_sgu_peer_fwd, dim3(grid), dim3(NTHREADS), LDS_BYTES, stream, a);
    }
#endif
}
```

```cpp
#include <hip/hip_runtime.h>
#include <hip/hip_bf16.h>
#include <hip/hip_cooperative_groups.h>
#include <cstdio>
#include <cstdint>
#include <cmath>
#define MK_LAUNCHES 1
namespace pg8 {
#define PG8_LAS __attribute__((address_space(3)))
typedef unsigned short bf16_t;
typedef short bf16x8 __attribute__((ext_vector_type(8)));
typedef float f32x4 __attribute__((ext_vector_type(4)));
typedef unsigned u32x4 __attribute__((ext_vector_type(4)));
constexpr int BM = 256, BK = 64, HALF = 128, HTB = HALF * BK * 2  , STAGE_BYTES = 8 * HTB, NXCD = 8, WGM = 8;

__host__ __device__ __forceinline__ int lds_byte(int r, int c) { const int st = (r >> 4) * 2 + (c >> 5), rr = r & 15, cc = c & 31, ob = rr * 64 + cc * 2; return st * 1024 + (ob ^ (((ob >> 9) & 1) << 5)); }
__host__ __device__ __forceinline__ void stage_rc(int b, int& R, int& C) { const int st = b / 1024, sb = b % 1024, swz = sb ^ (((sb >> 9) & 1) << 5); R = (st >> 1) * 16 + swz / 64; C = (st & 1) * 32 + (swz % 64) / 2; }
__host__ __device__ __forceinline__ int perm32(int rho) { const int n = rho >> 4, i = rho & 15; return 8 * (i >> 2) + 4 * n + (i & 3); }

struct Unit { int pm, pn; };
struct Gemm { const bf16_t* A; const bf16_t* Bt; int M, N, K; };

struct StaticOrder {
    int nM, nN, nwg, G, c;
    __host__ __device__ void init(int M, int N, int G_, int c_) { nM = M / BM; nN = N / BM; nwg = nM * nN; G = G_; c = c_; }
    __host__ __device__ bool next(int i, Unit& u) const {
        const long L = (long)i * G + c; if (L >= nwg) return false;
        int wgid = (int)L; { const int q = nwg / NXCD, r = nwg % NXCD, xcd = wgid % NXCD, off = wgid / NXCD; wgid = (xcd < r ? xcd * (q + 1) : r * (q + 1) + (xcd - r) * q) + off; }
        const int nig = WGM * nN, gid = wgid / nig, fm = gid * WGM, gsz = (nM - fm) < WGM ? (nM - fm) : WGM;
        u.pm = fm + ((wgid % nig) % gsz); u.pn = (wgid % nig) / gsz; return true;
    }
    __device__ __forceinline__ void a_ready(const Unit&) const {}
    __device__ __forceinline__ void done(const Unit&) const {}
};

__device__ __forceinline__ unsigned cvt_pk_bf16(float lo, float hi) { unsigned r; asm volatile("v_cvt_pk_bf16_f32 %0, %1, %2" : "=v"(r) : "v"(lo), "v"(hi)); return r; }
typedef float f32x2 __attribute__((ext_vector_type(2)));
template <class Epi, class Sched, bool ALIGN_EPI = false, bool SP2 = false>
__device__ __forceinline__ void gemm_phase(PG8_LAS unsigned char* lds, const Gemm g, const Sched& S, const Epi& E) {
    const int tid = threadIdx.x, wid = __builtin_amdgcn_readfirstlane(tid >> 6), lane = tid & 63, wr = wid >> 2, wc = wid & 3, fr = lane & 15, fq = lane >> 4;
    const int K = g.K, nt = K / BK;
    unsigned voffA[2], voffB[2];
#pragma unroll
    for (int i = 0; i < 2; ++i) { int R, C; stage_rc(tid * 16 + i * 8192, R, C); const int Rb = Epi::PERM ? ((R & ~31) + perm32(R & 31)) : R;
        voffA[i] = (unsigned)(R * K + C) * 2u; voffB[i] = (unsigned)(Rb * K + C) * 2u; }
    const size_t kstep = (size_t)(BK * 2);
    const size_t hstep = (size_t)HALF * K * 2;
    const size_t tstep = 2 * hstep;
    const unsigned ldsw = (unsigned)wid * 1024u;
    const int aoff = lds_byte(wr * 64 + fr, fq * 8), boff = lds_byte(wc * 32 + fr, fq * 8);
#define PG8_SA(b, h) (((b) * 2 + (h)) * HTB)
#define PG8_SB(b, h) ((4 + (b) * 2 + (h)) * HTB)
#define PG8_STAGE(bufoff, gbase, voff) do { _Pragma("unroll") for (int _i = 0; _i < 2; ++_i) \
        __builtin_amdgcn_global_load_lds((const unsigned*)((const char*)(gbase) + (voff)[_i]), (PG8_LAS unsigned*)(lds + (bufoff) + ldsw + _i * 8192), 16, 0, 0); } while (0)
#define PG8_LDA(dst, b, h) do { _Pragma("unroll") for (int m = 0; m < 4; ++m) _Pragma("unroll") for (int k = 0; k < 2; ++k) dst[m][k] = *(const PG8_LAS bf16x8*)(lds + PG8_SA(b, h) + aoff + m * 2048 + k * 1024); } while (0)
#define PG8_LDB(dst, b, h) do { _Pragma("unroll") for (int n = 0; n < 2; ++n) _Pragma("unroll") for (int k = 0; k < 2; ++k) dst[n][k] = *(const PG8_LAS bf16x8*)(lds + PG8_SB(b, h) + boff + n * 2048 + k * 1024); } while (0)
#define PG8_MMA(ai, bj, At, Bt) do { __builtin_amdgcn_s_setprio(1); _Pragma("unroll") for (int m = 0; m < 4; ++m) _Pragma("unroll") for (int n = 0; n < 2; ++n) _Pragma("unroll") for (int k = 0; k < 2; ++k) \
        acc[ai][bj][m][n] = __builtin_amdgcn_mfma_f32_16x16x32_bf16(Bt[n][k], At[m][k], acc[ai][bj][m][n], 0, 0, 0); __builtin_amdgcn_s_setprio(0); } while (0)
#define PG8_WAIT_V(n) asm volatile("s_waitcnt vmcnt(" #n ")" ::: "memory")
#define PG8_WAIT_L(n) asm volatile("s_waitcnt lgkmcnt(" #n ")" ::: "memory")
#define PG8_BAR __builtin_amdgcn_s_barrier()
#define PG8_SCHED __builtin_amdgcn_sched_barrier(0)
    Unit cur, nxt; int ui = 0;
    if (!S.next(0, cur)) return;
    f32x4 acc[2][2][4][2];
#pragma unroll
    for (int a = 0; a < 2; ++a)
#pragma unroll
        for (int b = 0; b < 2; ++b)
#pragma unroll
            for (int m = 0; m < 4; ++m)
#pragma unroll
                for (int n = 0; n < 2; ++n) acc[a][b][m][n] = (f32x4){0.f, 0.f, 0.f, 0.f};
    bf16x8 At[4][2], B0[2][2], B1[2][2];
    const char* cA = (const char*)g.A + (size_t)cur.pm * tstep; const char* cB = (const char*)g.Bt + (size_t)cur.pn * tstep;
    S.a_ready(cur);
    if constexpr (SP2) {
        PG8_STAGE(PG8_SB(0, 0), cB, voffB); PG8_STAGE(PG8_SB(0, 1), cB + hstep, voffB); PG8_STAGE(PG8_SA(0, 0), cA, voffA); PG8_STAGE(PG8_SA(0, 1), cA + hstep, voffA);
        if (wr == 1) PG8_BAR;
        PG8_WAIT_V(2); PG8_BAR;
        PG8_STAGE(PG8_SB(1, 0), cB + kstep, voffB); PG8_STAGE(PG8_SA(1, 0), cA + kstep, voffA); PG8_STAGE(PG8_SB(1, 1), cB + hstep + kstep, voffB);
        PG8_WAIT_V(6); PG8_BAR;
    } else {
        PG8_STAGE(PG8_SB(0, 0), cB, voffB); PG8_STAGE(PG8_SA(0, 0), cA, voffA); PG8_STAGE(PG8_SB(0, 1), cB + hstep, voffB); PG8_STAGE(PG8_SA(0, 1), cA + hstep, voffA);
        if (wr == 1) PG8_BAR;
        PG8_WAIT_V(4); PG8_BAR;
        PG8_STAGE(PG8_SB(1, 0), cB + kstep, voffB); PG8_STAGE(PG8_SA(1, 0), cA + kstep, voffA); PG8_STAGE(PG8_SB(1, 1), cB + hstep + kstep, voffB);
        PG8_WAIT_V(6); PG8_BAR;
    }
    for (;;) {
        const bool has_next = S.next(ui + 1, nxt);
        const char* nA = has_next ? (const char*)g.A + (size_t)nxt.pm * tstep : cA; const char* nB = has_next ? (const char*)g.Bt + (size_t)nxt.pn * tstep : cB;
        for (int t = 0; t < nt; t += 2) {
            const bool last = (t == nt - 2);
            const char* a1 = cA + (size_t)(t + 1) * kstep;
            const char* a2 = last ? nA : cA + (size_t)(t + 2) * kstep; const char* b2 = last ? nB : cB + (size_t)(t + 2) * kstep;
            const char* a3 = a2 + kstep; const char* b3 = b2 + kstep;
            if (last && has_next) S.a_ready(nxt);
            if constexpr (SP2) {
            PG8_LDB(B0, 0, 0); PG8_LDB(B1, 0, 1); PG8_SCHED; PG8_LDA(At, 0, 0); PG8_STAGE(PG8_SA(1, 1), a1 + hstep, voffA);
            PG8_WAIT_V(8); PG8_WAIT_L(0); PG8_BAR; PG8_MMA(0, 0, At, B0); PG8_MMA(0, 1, At, B1); PG8_BAR; PG8_SCHED;
            PG8_LDA(At, 0, 1); PG8_STAGE(PG8_SB(0, 0), b2, voffB); PG8_STAGE(PG8_SB(0, 1), b2 + hstep, voffB); PG8_STAGE(PG8_SA(0, 0), a2, voffA);
            PG8_WAIT_V(8); PG8_WAIT_L(0); PG8_BAR; PG8_MMA(1, 0, At, B0); PG8_MMA(1, 1, At, B1); PG8_BAR; PG8_SCHED;
            PG8_LDB(B0, 1, 0); PG8_LDB(B1, 1, 1); PG8_SCHED; PG8_LDA(At, 1, 0); PG8_STAGE(PG8_SA(0, 1), a2 + hstep, voffA);
            PG8_WAIT_V(8); PG8_WAIT_L(0); PG8_BAR; PG8_MMA(0, 0, At, B0); PG8_MMA(0, 1, At, B1); PG8_BAR; PG8_SCHED;
            PG8_LDA(At, 1, 1); PG8_STAGE(PG8_SB(1, 0), b3, voffB); PG8_STAGE(PG8_SB(1, 1), b3 + hstep, voffB); PG8_STAGE(PG8_SA(1, 0), a3, voffA);
            PG8_WAIT_V(8); PG8_WAIT_L(0); PG8_BAR; PG8_MMA(1, 0, At, B0); PG8_MMA(1, 1, At, B1); PG8_BAR; PG8_SCHED;
            } else {
            PG8_LDB(B0, 0, 0); PG8_SCHED; PG8_LDA(At, 0, 0); PG8_STAGE(PG8_SA(1, 1), a1 + hstep, voffA);
            PG8_WAIT_L(8); PG8_BAR; PG8_WAIT_L(0); PG8_MMA(0, 0, At, B0); PG8_BAR; PG8_SCHED;
            PG8_LDB(B1, 0, 1); PG8_STAGE(PG8_SB(0, 0), b2, voffB);
            PG8_BAR; PG8_WAIT_L(0); PG8_MMA(0, 1, At, B1); PG8_BAR;
            PG8_LDA(At, 0, 1); PG8_STAGE(PG8_SA(0, 0), a2, voffA);
            PG8_BAR; PG8_WAIT_L(0); PG8_MMA(1, 0, At, B0); PG8_BAR; PG8_SCHED;
            PG8_STAGE(PG8_SB(0, 1), b2 + hstep, voffB);
            PG8_WAIT_V(6); PG8_BAR; PG8_MMA(1, 1, At, B1); PG8_BAR;
            PG8_LDB(B0, 1, 0); PG8_SCHED; PG8_LDA(At, 1, 0); PG8_STAGE(PG8_SA(0, 1), a2 + hstep, voffA);
            PG8_WAIT_L(8); PG8_BAR; PG8_WAIT_L(0); PG8_MMA(0, 0, At, B0); PG8_BAR; PG8_SCHED;
            PG8_LDB(B1, 1, 1); PG8_STAGE(PG8_SB(1, 0), b3, voffB);
            PG8_BAR; PG8_WAIT_L(0); PG8_MMA(0, 1, At, B1); PG8_BAR;
            PG8_LDA(At, 1, 1); PG8_STAGE(PG8_SA(1, 0), a3, voffA);
            PG8_BAR; PG8_WAIT_L(0); PG8_MMA(1, 0, At, B0); PG8_BAR; PG8_SCHED;
            PG8_STAGE(PG8_SB(1, 1), b3 + hstep, voffB);
            PG8_WAIT_V(6); PG8_BAR; PG8_MMA(1, 1, At, B1); PG8_BAR;
            }
        }
        if constexpr (ALIGN_EPI) { if (wr == 0) PG8_BAR; }
        if constexpr (!Epi::AFTER_DRAIN) { E(acc, cur, wr, wc, fr, fq); S.done(cur); }
        if (!has_next) break;
#pragma unroll
        for (int a = 0; a < 2; ++a)
#pragma unroll
            for (int b = 0; b < 2; ++b)
#pragma unroll
                for (int m = 0; m < 4; ++m)
#pragma unroll
                    for (int n = 0; n < 2; ++n) acc[a][b][m][n] = (f32x4){0.f, 0.f, 0.f, 0.f};
        cur = nxt; cA = nA; cB = nB; ++ui;
        if constexpr (ALIGN_EPI) { if (wr == 1) PG8_BAR; }
    }
    PG8_WAIT_V(0);
    if constexpr (!ALIGN_EPI) { if (wr == 0) PG8_BAR; }
    PG8_BAR;
    if constexpr (Epi::AFTER_DRAIN) { E.fused(acc, cur, wr, wc, fr, fq, lds, wid, lane); S.done(cur); }
#undef PG8_SA
#undef PG8_SB
#undef PG8_STAGE
#undef PG8_LDA
#undef PG8_LDB
#undef PG8_MMA
#undef PG8_WAIT_V
#undef PG8_WAIT_L
#undef PG8_BAR
#undef PG8_SCHED
}
}
namespace attn {
constexpr int D = 128, NW = 8, QBLK = 32, KVBLK = 64, QB = NW * QBLK;
constexpr int SHM_V = KVBLK * D * 2, SHM_K = KVBLK * D * 2;
constexpr int LDS_BYTES = 2 * SHM_V + 2 * SHM_K + NW * 64 * 4;
constexpr float SCALE = 0.08838834764831845f;
#ifndef OSTR_V
#define OSTR_V 1024
#endif
constexpr float THR = 20.f;
constexpr bool WSKIP = false;
constexpr bool NO_SEAM_PREFETCH = true;
constexpr int OSTR = OSTR_V;
using bf16 = __hip_bfloat16;
typedef short bf16x8 __attribute__((ext_vector_type(8)));
typedef short s16x4 __attribute__((ext_vector_type(4)));
typedef float f32x16 __attribute__((ext_vector_type(16)));
typedef float f32x4 __attribute__((ext_vector_type(4)));
typedef unsigned u32x4 __attribute__((ext_vector_type(4)));
template <class A, class Bt> struct same_t { static constexpr bool v = false; };
template <class A> struct same_t<A, A> { static constexpr bool v = true; };

#define KSWZ(row, colB) ((row) * 256 + ((colB) ^ (((row) & 7) << 4)))
#define SBAR() __builtin_amdgcn_sched_barrier(0)
__device__ __forceinline__ int v_st(int k, int c) { const int kk = (k & ~0xC) | ((k & 4) << 1) | ((k & 8) >> 1); return ((kk >> 3) * 4 + (c >> 5)) * 512 + ((kk & 7) * 32 + (c & 31)) * 2; }
__device__ __forceinline__ int v_rd_base(int lane) { return ((lane & 3) << 3) | (((lane >> 2) & 3) << 6) | (((lane >> 4) & 1) << 5) | (((lane >> 5) & 1) << 8); }
constexpr int v_rd_off(int d0, int ks, int half) { return d0 * 512 + ks * 4096 + half * 2048; }
__device__ __forceinline__ int crow(int r, int hi) { return (r & 3) + 8 * (r >> 2) + 4 * hi; }
__device__ __forceinline__ unsigned cvtpk(float lo, float hi) {
    unsigned r; asm volatile("v_cvt_pk_bf16_f32 %0, %1, %2" : "=v"(r) : "v"(lo), "v"(hi)); return r;
}
__device__ __forceinline__ bf16x8 pack8(f32x4 a, f32x4 b) {
    u32x4 w = {cvtpk(a[0], a[1]), cvtpk(a[2], a[3]), cvtpk(b[0], b[1]), cvtpk(b[2], b[3])};
    return *reinterpret_cast<bf16x8*>(&w);
}
template <class T> __device__ __forceinline__ bf16x8 load8(const T* p) {
    if constexpr (same_t<T, float>::v) { return pack8(*(const f32x4*)p, *(const f32x4*)(p + 4)); }
    else { return *reinterpret_cast<const bf16x8*>(p); }
}
__device__ __forceinline__ void mask_tile(f32x16& p0, f32x16& p1, int dq, unsigned W) {
    const float NEG = -__builtin_inff();
#pragma unroll
    for (int r = 0; r < 16; ++r) {
        const int c = (r & 3) + 8 * (r >> 2);
        if ((unsigned)(dq - c) >= W) p0[r] = NEG;
        if ((unsigned)(dq - c - 32) >= W) p1[r] = NEG;
    }
}
__device__ __forceinline__ void partialSM(f32x16& p0, f32x16& p1, float& m_reg, float& mn, float& alpha) {
    float pmax = p0[0]; for (int r = 1; r < 16; ++r) pmax = fmaxf(pmax, p0[r]); for (int r = 0; r < 16; ++r) pmax = fmaxf(pmax, p1[r]);
    { auto rr = __builtin_amdgcn_permlane32_swap(__float_as_uint(pmax), __float_as_uint(pmax), false, false);
      pmax = fmaxf(__uint_as_float(rr[0]), __uint_as_float(rr[1])); }
    constexpr float C2 = 1.4426950408889634f * SCALE;
    if (__builtin_expect(__all((pmax - m_reg) * SCALE <= THR), 1)) { mn = m_reg; alpha = 1.f; }
    else { mn = fmaxf(m_reg, pmax); alpha = __builtin_amdgcn_exp2f((m_reg - mn) * C2); m_reg = mn; }
    const float mnL = -mn * C2;
    for (int r = 0; r < 16; ++r) p0[r] = fmaf(p0[r], C2, mnL); for (int r = 0; r < 16; ++r) p1[r] = fmaf(p1[r], C2, mnL);
    for (int r = 0; r < 16; ++r) p0[r] = __builtin_amdgcn_exp2f(p0[r]);
}
__device__ __forceinline__ void finishSM(f32x16& p0, f32x16& p1, float alpha, float& l_reg, bf16x8& pa0, bf16x8& pa1, bf16x8& pa2, bf16x8& pa3) {
    for (int r = 0; r < 16; ++r) p1[r] = __builtin_amdgcn_exp2f(p1[r]);
    float ps = 0; for (int r = 0; r < 16; ++r) ps += p0[r]; for (int r = 0; r < 16; ++r) ps += p1[r];
    { auto rr = __builtin_amdgcn_permlane32_swap(__float_as_uint(ps), __float_as_uint(ps), false, false);
      ps = __uint_as_float(rr[0]) + __uint_as_float(rr[1]); }
    l_reg = l_reg * alpha + ps;
#define PK4(P, B_, OUT) do { unsigned a0 = cvtpk(P[B_+0], P[B_+1]), a1 = cvtpk(P[B_+2], P[B_+3]);                          \
        unsigned b0 = cvtpk(P[B_+4], P[B_+5]), b1 = cvtpk(P[B_+6], P[B_+7]);                                             \
        auto r0 = __builtin_amdgcn_permlane32_swap(a0, b0, false, false); auto r1 = __builtin_amdgcn_permlane32_swap(a1, b1, false, false); \
        u32x4 w = {r0[0], r1[0], r0[1], r1[1]}; OUT = *reinterpret_cast<bf16x8*>(&w); } while (0)
    PK4(p0, 0, pa0); PK4(p0, 8, pa1); PK4(p1, 0, pa2); PK4(p1, 8, pa3);
#undef PK4
}
template <int KB, bool SK>
__device__ __forceinline__ void qkt(f32x16& p0, f32x16& p1, const char* K_lds, int r32, int hi, const bf16x8* qr, bool act, const float* bt) {
    if (SK && !act) { const float NEG = -__builtin_inff();
#pragma unroll
        for (int r = 0; r < 16; ++r) { p0[r] = NEG; p1[r] = NEG; } return; }
#ifdef NO_BIAS
    p0 = f32x16{}; p1 = f32x16{};
#else
    {
#pragma unroll
        for (int j = 0; j < 4; ++j) { const f32x4 a = *(const f32x4*)(bt + 8 * j), b = *(const f32x4*)(bt + 32 + 8 * j);
            p0[4 * j] = a[0]; p0[4 * j + 1] = a[1]; p0[4 * j + 2] = a[2]; p0[4 * j + 3] = a[3]; p1[4 * j] = b[0]; p1[4 * j + 1] = b[1]; p1[4 * j + 2] = b[2]; p1[4 * j + 3] = b[3]; } }
#endif
    const char* kb[4];
#pragma unroll
    for (int dd = 0; dd < 4; ++dd) kb[dd] = K_lds + KB * SHM_K + KSWZ(r32, (dd * 16 + hi * 8) * 2);
#pragma unroll
    for (int d0 = 0; d0 < 8; ++d0) { const char* a = kb[d0 & 3] + (d0 >> 2) * 128;
        bf16x8 b0 = *reinterpret_cast<const bf16x8*>(a);
        bf16x8 b1 = *reinterpret_cast<const bf16x8*>(a + 32 * 256);
        p0 = __builtin_amdgcn_mfma_f32_32x32x16_bf16(b0, qr[d0], p0, 0, 0, 0);
        p1 = __builtin_amdgcn_mfma_f32_32x32x16_bf16(b1, qr[d0], p1, 0, 0, 0); }
}
template <int VB, bool SK>
__device__ __forceinline__ void pv_tile(f32x16* o, int vb0, bf16x8 pa0, bf16x8 pa1, bf16x8 pa2, bf16x8 pa3, bool act) {
    if (SK && !act) return;
#define TRRD(dst, off) asm volatile("ds_read_b64_tr_b16 %0, %1 offset:%2" : "=&v"(dst) : "v"(vb0), "i"(off) : "memory")
#define PV_D0(d0) do { s16x4 l0, l1, l2, l3, h0, h1, h2, h3; constexpr int b_ = VB * SHM_V + v_rd_off(d0, 0, 0);     \
        TRRD(l0, b_); TRRD(h0, b_ + 2048); TRRD(l1, b_ + 4096); TRRD(h1, b_ + 6144); TRRD(l2, b_ + 8192); TRRD(h2, b_ + 10240); TRRD(l3, b_ + 12288); TRRD(h3, b_ + 14336); \
        asm volatile("s_waitcnt lgkmcnt(0)" ::: "memory"); SBAR();                 \
        o[d0] = __builtin_amdgcn_mfma_f32_32x32x16_bf16(pa0, (bf16x8){l0[0], l0[1], l0[2], l0[3], h0[0], h0[1], h0[2], h0[3]}, o[d0], 0, 0, 0);   \
        o[d0] = __builtin_amdgcn_mfma_f32_32x32x16_bf16(pa1, (bf16x8){l1[0], l1[1], l1[2], l1[3], h1[0], h1[1], h1[2], h1[3]}, o[d0], 0, 0, 0);   \
        o[d0] = __builtin_amdgcn_mfma_f32_32x32x16_bf16(pa2, (bf16x8){l2[0], l2[1], l2[2], l2[3], h2[0], h2[1], h2[2], h2[3]}, o[d0], 0, 0, 0);   \
        o[d0] = __builtin_amdgcn_mfma_f32_32x32x16_bf16(pa3, (bf16x8){l3[0], l3[1], l3[2], l3[3], h3[0], h3[1], h3[2], h3[3]}, o[d0], 0, 0, 0); } while (0)
    PV_D0(0); PV_D0(1); PV_D0(2); PV_D0(3);
#undef PV_D0
#undef TRRD
}

template <class TIn, class TOut> struct BlockRef { const TIn* Q; const TIn* K; const TIn* V; TOut* O; int P0; int jlo; };
template <class TIn> struct Seam {
    bf16x8 qr[8];
    bf16x8 st_v0, st_v1, st_k0, st_k1; f32x4 sf0, sf1, sf2, sf3;
    f32x4 tq[16];
};
__device__ __forceinline__ int swa_jlo(int P0, int W) { const int lowk = P0 - W + 1; return lowk > 0 ? lowk / KVBLK : 0; }
#define ROW(p, k0, rr) ((p) + (size_t)((k0) + (rr)) * D + sc)
#define VMW() asm volatile("s_waitcnt vmcnt(0)" ::: "memory")
#define VMWN(n) asm volatile("s_waitcnt vmcnt(%0)" :: "i"(n) : "memory")
#define SLOAD_H(Kp, Vp, k0) do { S.st_v0 = load8<TIn>(ROW(Vp, k0, sr)); S.st_v1 = load8<TIn>(ROW(Vp, k0, 32 + sr));              \
                         S.st_k0 = load8<TIn>(ROW(Kp, k0, sr)); S.st_k1 = load8<TIn>(ROW(Kp, k0, 32 + sr)); } while (0)
#define SWRITE_HK(bf) do { *(bf16x8*)(K_lds + (bf) * SHM_K + kws) = S.st_k0; *(bf16x8*)(K_lds + (bf) * SHM_K + kws + 32 * 256) = S.st_k1; } while (0)
#define SWRITE_HV(bf) do { *(bf16x8*)(V_lds + (bf) * SHM_V + vst0) = S.st_v0; *(bf16x8*)(V_lds + (bf) * SHM_V + vst1) = S.st_v1; } while (0)
#define SWRITE_H(bf) do { SWRITE_HV(bf); SWRITE_HK(bf); } while (0)
#define SLOAD_F(p, k0) do { S.sf0 = *(const f32x4*)ROW(p, k0, sr); S.sf1 = *(const f32x4*)(ROW(p, k0, sr) + 4);                \
                            S.sf2 = *(const f32x4*)ROW(p, k0, 32 + sr); S.sf3 = *(const f32x4*)(ROW(p, k0, 32 + sr) + 4); } while (0)
#define SWRITE_KF(bf) do { *(bf16x8*)(K_lds + (bf) * SHM_K + kws) = pack8(S.sf0, S.sf1); *(bf16x8*)(K_lds + (bf) * SHM_K + kws + 32 * 256) = pack8(S.sf2, S.sf3); } while (0)
#define SWRITE_VF(bf) do { *(bf16x8*)(V_lds + (bf) * SHM_V + vst0) = pack8(S.sf0, S.sf1); *(bf16x8*)(V_lds + (bf) * SHM_V + vst1) = pack8(S.sf2, S.sf3); } while (0)
template <class TIn, class TOut>
__device__ __forceinline__ void causal_swa_prime(const BlockRef<TIn, TOut>& cur, int W, char* lds, Seam<TIn>& S) {
    constexpr bool F32 = same_t<TIn, float>::v;
    int tid_o = threadIdx.x;
#ifndef NO_OPAQ
    asm volatile("" : "+v"(tid_o));
#endif
    const int tid = tid_o, wid = __builtin_amdgcn_readfirstlane(tid >> 6), lane = tid & 63, r32 = lane & 31, hi = lane >> 5;
    const int sr = tid >> 4, sc = (tid & 15) * 8, kws = KSWZ(sr, sc * 2); char* K_lds = lds + 2 * SHM_V;
    const int kb0 = cur.jlo * KVBLK;
    for (int d0 = 0; d0 < 8; ++d0) S.qr[d0] = load8<TIn>(cur.Q + (size_t)(wid * QBLK + r32) * D + d0 * 16 + hi * 8);
    if constexpr (F32) { SLOAD_F((const float*)cur.K, kb0); VMW(); SWRITE_KF(0); SBAR(); SLOAD_F((const float*)cur.V, kb0); }
    else { SLOAD_H(cur.K, cur.V, kb0); VMW(); SWRITE_HK(0); }
    __syncthreads();
}
template <class TIn, class TOut>
__device__ __forceinline__ void causal_swa_block(const BlockRef<TIn, TOut>& cur, const BlockRef<TIn, TOut>& nxt, int skv, int W, char* lds, Seam<TIn>& S, const float* bias_lds) {
    constexpr bool F32 = same_t<TIn, float>::v;
    int tid_o = threadIdx.x;
#ifndef NO_OPAQ
    asm volatile("" : "+v"(tid_o));
#endif
    const int tid = tid_o, wid = __builtin_amdgcn_readfirstlane(tid >> 6), lane = tid & 63, r32 = lane & 31, hi = lane >> 5;
    const int j_lo = cur.jlo;
    int j_hi = (cur.P0 + QB - 1) / KVBLK + 1; if (j_hi > skv / KVBLK) j_hi = skv / KVBLK;
    const int NT = j_hi - j_lo;
    const int kbn = nxt.jlo * KVBLK;
    const int qlo = cur.P0 + wid * QBLK, qm = qlo + r32 - 4 * hi;
    char* V_lds = lds; char* K_lds = lds + 2 * SHM_V;
    float* ws = (float*)(lds + 2 * SHM_V + 2 * SHM_K) + wid * 64; float* li_l = ws, * al_l = ws + 32;
    float m_reg = -1e30f, l_reg = 0; f32x16 o[4] = {};
    const int sr = tid >> 4, sc = (tid & 15) * 8, vst0 = v_st(sr, sc), vst1 = v_st(32 + sr, sc), kws = KSWZ(sr, sc * 2);
    const int vb0 = (int)(uintptr_t)V_lds + v_rd_base(lane);
    const TIn* Kh = cur.K; const TIn* Vh = cur.V;
#define RESC(a) do { if (__any((a) < 1.f)) { if (hi == 0) al_l[r32] = (a); asm volatile("s_waitcnt lgkmcnt(0)" ::: "memory");              \
                     for (int d_ = 0; d_ < 4; ++d_) for (int r = 0; r < 16; ++r) o[d_][r] *= al_l[crow(r, hi)]; } } while (0)
#define KBASE(t) ((j_lo + (t)) * KVBLK)
#define BT(t) (bias_lds + KBASE(t) + 4 * hi)
#define ACT(t) (KBASE(t) <= qlo + QBLK - 1 && KBASE(t) + KVBLK - 1 >= qlo - W + 1)
#define MASKT(P0_, P1_, t) do { const int kb_ = KBASE(t); if ((!SK || ACT(t)) && (kb_ + KVBLK - 1 > qlo || kb_ <= qlo + QBLK - 1 - W)) mask_tile(P0_, P1_, qm - kb_, (unsigned)W); } while (0)
    constexpr int NQL = F32 ? 16 : 8;
    constexpr bool SK = WSKIP && !F32;
#define SEAM_K0() do { VMWN(NQL); if constexpr (F32) { SWRITE_KF(0); SBAR(); SLOAD_F((const float*)nxt.V, kbn); } else { SWRITE_HK(0); } SBAR(); } while (0)
    f32x16 pA0, pA1, pB0, pB1; float mnA, mnB, alA, alB; bf16x8 pa0, pa1, pa2, pa3;
    if constexpr (F32) { VMW(); SWRITE_VF(0); SBAR(); } else { SWRITE_HV(0); SBAR(); }
    if (NT > 1) { if constexpr (F32) SLOAD_F((const float*)Kh, KBASE(1)); else SLOAD_H(Kh, Vh, KBASE(1)); }
    SBAR(); qkt<0, SK>(pA0, pA1, K_lds, r32, hi, S.qr, ACT(0), BT(0));
    if constexpr (F32) { if (NT > 1) { VMW(); SWRITE_KF(1); SBAR(); SLOAD_F((const float*)Vh, KBASE(1)); } }
    MASKT(pA0, pA1, 0); partialSM(pA0, pA1, m_reg, mnA, alA);
    if (NT > 1) { VMW(); if constexpr (F32) { SWRITE_VF(1); SBAR(); if (NT > 2) SLOAD_F((const float*)Kh, KBASE(2)); } else SWRITE_H(1); }
    __syncthreads();
#define HALF_STEP(PX0, PX1, mnX, alX, PY0, PY1, alY, t, KB, VB, SB) do {                                                      \
        SBAR(); qkt<KB, SK>(PX0, PX1, K_lds, r32, hi, S.qr, ACT(t), BT(t));                                             \
        finishSM(PY0, PY1, alY, l_reg, pa0, pa1, pa2, pa3); SBAR();                                                           \
        if ((t) + 1 < NT) { if constexpr (F32) { VMW(); SWRITE_KF(SB); SBAR(); SLOAD_F((const float*)Vh, KBASE((t) + 1)); }  \
                            else { SLOAD_H(Kh, Vh, KBASE((t) + 1)); } SBAR(); }                                               \
        pv_tile<VB, SK>(o, vb0, pa0, pa1, pa2, pa3, ACT((t) - 1)); MASKT(PX0, PX1, (t)); partialSM(PX0, PX1, m_reg, mnX, alX);                                        \
        __syncthreads();                                                                                                      \
        if ((t) + 1 < NT) { VMW(); if constexpr (F32) { SWRITE_VF(SB); SBAR(); if ((t) + 2 < NT) SLOAD_F((const float*)Kh, KBASE((t) + 2)); } \
                            else { SWRITE_H(SB); } }                                                                          \
        RESC(alX); __syncthreads(); } while (0)
    for (int t = 1; t + 1 < NT; t += 2) {
        HALF_STEP(pB0, pB1, mnB, alB, pA0, pA1, alA, t, 1, 0, 0);
        HALF_STEP(pA0, pA1, mnA, alA, pB0, pB1, alB, t + 1, 0, 1, 1);
    }
    const bool even = (NT & 1) == 0;
    if (even) { SBAR(); qkt<1, SK>(pB0, pB1, K_lds, r32, hi, S.qr, ACT(NT - 1), BT(NT - 1)); SBAR(); }
#define QROW(e) (nxt.Q + (size_t)(wid * QBLK + r32) * D + ((e) >> 1) * 16 + hi * 8 + ((e) & 1) * 4)
    if constexpr (F32) { SLOAD_F((const float*)nxt.K, kbn); SBAR();
#pragma unroll
        for (int e = 0; e < 8; ++e) S.tq[e] = *(const f32x4*)QROW(e); }
    else if (!NO_SEAM_PREFETCH) { SLOAD_H(nxt.K, nxt.V, kbn); SBAR();
#pragma unroll
        for (int d0 = 0; d0 < 8; ++d0) S.qr[d0] = load8<TIn>(nxt.Q + (size_t)(wid * QBLK + r32) * D + d0 * 16 + hi * 8); }
    SBAR();
    finishSM(pA0, pA1, alA, l_reg, pa0, pa1, pa2, pa3); SBAR();
    if constexpr (F32) {
#pragma unroll
        for (int e = 8; e < 16; ++e) S.tq[e] = *(const f32x4*)QROW(e); SBAR(); }
#undef QROW
    pv_tile<0, SK>(o, vb0, pa0, pa1, pa2, pa3, ACT(even ? NT - 2 : NT - 1));
    if (even) { MASKT(pB0, pB1, NT - 1); partialSM(pB0, pB1, m_reg, mnB, alB); __syncthreads(); RESC(alB);
        finishSM(pB0, pB1, alB, l_reg, pa0, pa1, pa2, pa3); SBAR(); pv_tile<1, SK>(o, vb0, pa0, pa1, pa2, pa3, ACT(NT - 1)); }
    SBAR(); if (!NO_SEAM_PREFETCH) SEAM_K0();
    if (hi == 0) li_l[r32] = l_reg; asm volatile("s_waitcnt lgkmcnt(0)" ::: "memory");
    float rli[16];
#pragma unroll
    for (int r = 0; r < 16; ++r) rli[r] = __builtin_amdgcn_rcpf(li_l[crow(r, hi)]);
    TOut* Ow = cur.O + (size_t)(wid * QBLK) * OSTR;
#pragma unroll
    for (int r = 0; r < 16; ++r) { const int orow = crow(r, hi);
#pragma unroll
        for (int d0 = 0; d0 < 4; ++d0) { const float v = o[d0][r] * rli[r];
            if constexpr (same_t<TOut, float>::v) { Ow[(size_t)orow * OSTR + d0 * 32 + r32] = v; }
            else { const float vn = __shfl_xor(v, 1);
                   if ((r32 & 1) == 0) *(unsigned*)(Ow + (size_t)orow * OSTR + d0 * 32 + r32) = cvtpk(v, vn); } } }
    if constexpr (F32) {
#pragma unroll
        for (int d0 = 0; d0 < 8; ++d0) S.qr[d0] = pack8(S.tq[2 * d0], S.tq[2 * d0 + 1]); }
    __syncthreads();
#undef RESC
#undef KBASE
#undef BT
#undef ACT
#undef MASKT
#undef SEAM_K0
#undef HALF_STEP
}
#undef ROW
#undef VMW
#undef VMWN
#undef SLOAD_H
#undef SWRITE_HK
#undef SWRITE_HV
#undef SWRITE_H
#undef SLOAD_F
#undef SWRITE_KF
#undef SWRITE_VF
#undef KSWZ
#undef SBAR
}
#define GAS __attribute__((address_space(1)))
#define LAS __attribute__((address_space(3)))
typedef unsigned short hbf;
typedef unsigned v4u __attribute__((ext_vector_type(4)));
typedef unsigned v2u __attribute__((ext_vector_type(2)));
typedef float f32x4 __attribute__((ext_vector_type(4)));
typedef float f32x16 __attribute__((ext_vector_type(16)));
typedef short bf16x8 __attribute__((ext_vector_type(8)));
typedef __bf16 bf16x2_t __attribute__((ext_vector_type(2)));

constexpr int DM = 2048, NBATCH = 2, SEQ = 8192, DBATCH = 16, DSEQ = 16, PAST = 4096;
constexpr int MP = NBATCH * SEQ, MS = DBATCH * DSEQ, MT = MP + MS;
constexpr int FH = 8, FD = 128, FW = FH * FD, SGW = 1024, SGG = 8, SGC = 128;
constexpr int INW = 9224, NZ = 9216;
constexpr int PEH = 8, PEK = 128, PED = 256, NEXP = 16384;
constexpr float EPS = 1e-6f;
constexpr int SKEYS = PAST + DSEQ, SBP = 4128;
constexpr int NTM = MT / 256;
constexpr float LOG2E = 1.4426950408889634f;

constexpr size_t O_Y = 0, O_KP = (size_t)MT * DM, O_VP = O_KP + (size_t)MP * FW, O_LFP = O_VP + (size_t)MP * FW, O_KS = O_LFP + (size_t)MP * FH,
                 O_VS = O_KS + (size_t)MS * FW, O_LFS = O_VS + (size_t)MS * FW, O_SGV = O_LFS + (size_t)MS * FH, O_END = O_SGV + (size_t)MS * SGW;
static_assert(O_END == 68552704, "output map");

constexpr size_t MiB = 1u << 20;
constexpr size_t WS_CTL = 0, CTL_BYTES = 1 * MiB;
constexpr size_t WS_WIN = 2 * MiB, WS_WAB = 38 * MiB, WS_WO = 46 * MiB, WS_WPQ = 54 * MiB, WS_SK = 62 * MiB, WS_WSP = 62 * MiB + 512 * 1024;
constexpr size_t WS_TU = 64 * MiB, WS_TV = 128 * MiB, WS_H = 192 * MiB, WS_Q = 257 * MiB, WS_QS = 289 * MiB, WS_K = 290 * MiB, WS_V = 322 * MiB;
constexpr size_t WS_US = 354 * MiB, WS_VS = 387 * MiB, WS_GA = 420 * MiB, WS_GB = 485 * MiB, WS_OA = 550 * MiB, WS_OB = WS_OA + (size_t)MT * FW * 2;
constexpr size_t WS_Y = 615 * MiB, WS_XG = 680 * MiB, WS_QN = 745 * MiB, WS_EI = 810 * MiB, WS_GW = 819 * MiB, WS_PB = 828 * MiB, WS_SB = 829 * MiB;
constexpr size_t WS_VSSQ = 832 * MiB, WS_XSSQ = 834 * MiB, WS_RS0 = 836 * MiB + 512 * 1024, WS_END = 837 * MiB;
constexpr size_t WS_X1 = WS_H;
static_assert(WS_X1 + (size_t)MT * DM * 4 <= WS_US, "x1 overlay");
static_assert(WS_XSSQ + (size_t)MT * 32 * 4 <= WS_RS0 && WS_RS0 + (size_t)MT * 4 <= WS_END, "ws tail");
static_assert(WS_OB + (size_t)MT * FW * 2 <= WS_Y && WS_H + (size_t)MT * DM * 2 <= WS_Q && WS_WIN + (size_t)NZ * DM * 2 <= WS_WAB, "ws map");

constexpr int LDS_BYTES = 160 * 1024, LDS_STAT = 128 * 1024, LDS_XB = LDS_BYTES - 64;
constexpr int CW_BAR = 1024, CW_CHAIN = 5120, NCHAIN = 8; constexpr size_t CTL_ZERO = 32 * 1024;
constexpr int NTHREADS = 512, NWAVES = 8;

__device__ __forceinline__ float wave_sum(float v) {
#pragma unroll
    for (int o = 1; o < 64; o <<= 1) v += __shfl_xor(v, o);
    return v;
}
#define DPP_STEP(v, ctrl, rmask) ((v) + __builtin_bit_cast(float, __builtin_amdgcn_update_dpp(0, __builtin_bit_cast(int, (v)), (ctrl), (rmask), 0xF, false)))
__device__ __forceinline__ float wave_sum_dpp(float v) {
    v = DPP_STEP(v, 0xB1, 0xF);
    v = DPP_STEP(v, 0x4E, 0xF);
    v = DPP_STEP(v, 0x141, 0xF);
    v = DPP_STEP(v, 0x140, 0xF);
    v = DPP_STEP(v, 0x142, 0xA);
    v = DPP_STEP(v, 0x143, 0xC);
    return __builtin_bit_cast(float, __builtin_amdgcn_readlane(__builtin_bit_cast(int, v), 63));
}
__device__ __forceinline__ unsigned pk2(float lo, float hi) { unsigned r; asm volatile("v_cvt_pk_bf16_f32 %0, %1, %2" : "=v"(r) : "v"(lo), "v"(hi)); return r; }
__device__ __forceinline__ float bflo(unsigned u) { return __uint_as_float(u << 16); }
__device__ __forceinline__ float bfhi(unsigned u) { return __uint_as_float(u & 0xffff0000u); }
__device__ __forceinline__ float gelu_tanh(float x) {
    const float u = 0.7978845608028654f * (x + 0.044715f * x * x * x);
    return x * __builtin_amdgcn_rcpf(1.0f + __builtin_amdgcn_exp2f(-2.0f * LOG2E * u));
}
__device__ __forceinline__ float sigmoidf_(float x) { return __builtin_amdgcn_rcpf(1.0f + __builtin_amdgcn_exp2f(-LOG2E * x)); }
__device__ __forceinline__ float log_sigmoid(float z) { return fminf(z, 0.f) - log1pf(expf(-fabsf(z))); }

struct Frame {
    LAS unsigned char* lds; unsigned char* lds_g;
    int tid, lane, wave, G, vcu, probe;
    const float* const* in;
    float* out; unsigned char* ws;
};
__device__ __forceinline__ const float* xrow(const Frame& F, int m) { return m < MP ? F.in[0] + (size_t)m * DM : F.in[1] + (size_t)(m - MP) * DM; }

__device__ __forceinline__ void p0_transpose_item(const float* W, int ldw, int K, hbf* WT, int nblk, int nsplit, int nskip, LAS float* scr, int item, int lane, const float* kg = nullptr) {
    const int kb = item / nblk, nb = item % nblk, k0 = 64 * kb, n0 = 32 * nb, s0 = n0 + (n0 >= nsplit ? nskip : 0);
#pragma unroll 8
    for (int i = 0; i < 32; ++i) { const int kk = 2 * i + (lane >> 5); scr[kk * 33 + (lane & 31)] = W[(size_t)(k0 + kk) * ldw + s0 + (lane & 31)]; }
    asm volatile("s_waitcnt lgkmcnt(0)" ::: "memory");
    const int c = lane & 7;
    f32x4 ka = {1.f, 1.f, 1.f, 1.f}, kb4 = ka; if (kg) { ka = *(const f32x4*)(kg + k0 + 8 * c); kb4 = *(const f32x4*)(kg + k0 + 8 * c + 4); }
#pragma unroll
    for (int j = 0; j < 4; ++j) { const int n = (lane >> 3) + 8 * j; const LAS float* s = scr + (8 * c) * 33 + n;
        v4u o; o.x = pk2(s[0 * 33] * ka[0], s[1 * 33] * ka[1]); o.y = pk2(s[2 * 33] * ka[2], s[3 * 33] * ka[3]); o.z = pk2(s[4 * 33] * kb4[0], s[5 * 33] * kb4[1]); o.w = pk2(s[6 * 33] * kb4[2], s[7 * 33] * kb4[3]);
        *(v4u*)(WT + (size_t)(n0 + n) * K + k0 + 8 * c) = o; }
    asm volatile("s_waitcnt lgkmcnt(0)" ::: "memory");
}
__device__ __forceinline__ void cvt8(const float* src, hbf* dst, size_t i8) {
    const f32x4 a = *(const f32x4*)(src + i8 * 8), b = *(const f32x4*)(src + i8 * 8 + 4);
    v4u o; o.x = pk2(a[0], a[1]); o.y = pk2(a[2], a[3]); o.z = pk2(b[0], b[1]); o.w = pk2(b[2], b[3]);
    *(v4u*)(dst + i8 * 8) = o;
}
__device__ __forceinline__ unsigned pk8_fp4(f32x4 a, f32x4 b, float sc) {
    unsigned p = 0;
    p = __builtin_amdgcn_cvt_scalef32_pk_fp4_f32(p, a[0] * sc, a[1] * sc, 1.0f, 0); p = __builtin_amdgcn_cvt_scalef32_pk_fp4_f32(p, a[2] * sc, a[3] * sc, 1.0f, 1);
    p = __builtin_amdgcn_cvt_scalef32_pk_fp4_f32(p, b[0] * sc, b[1] * sc, 1.0f, 2); p = __builtin_amdgcn_cvt_scalef32_pk_fp4_f32(p, b[2] * sc, b[3] * sc, 1.0f, 3);
    return p;
}
__device__ __forceinline__ void cvt32_fp4(const float* src, unsigned char* dst, size_t i32, float sc) {
    const f32x4* s4 = (const f32x4*)(src + i32 * 32);
    v4u o; o.x = pk8_fp4(s4[0], s4[1], sc); o.y = pk8_fp4(s4[2], s4[3], sc); o.z = pk8_fp4(s4[4], s4[5], sc); o.w = pk8_fp4(s4[6], s4[7], sc);
    *(v4u*)(dst + i32 * 16) = o;
}
constexpr int P0_I_IN = (DM / 64) * (NZ / 32), P0_I_A = (FW / 64) * (DM / 32), P0_I_O = (DM / 64) * (DM / 32);
#define P0_LATE_OK(F) ((F).G == 256)
__device__ __forceinline__ void late_weights(const Frame& F, LAS float* scr, int gw, int NGW) {
    constexpr int I_A = P0_I_A, I_O = P0_I_O;
    for (int it = gw; it < 2 * I_A + 2 * I_O; it += NGW) {
        int r = it;
        if (r < I_A) { p0_transpose_item(F.in[13], DM, FW, (hbf*)(F.ws + WS_WAB), DM / 32, 1 << 30, 0, scr, r, F.lane); continue; } r -= I_A;
        if (r < I_A) { p0_transpose_item(F.in[14], DM, FW, (hbf*)(F.ws + WS_WAB) + (size_t)DM * FW, DM / 32, 1 << 30, 0, scr, r, F.lane); continue; } r -= I_A;
        if (r < I_O) { p0_transpose_item(F.in[15], DM, DM, (hbf*)(F.ws + WS_WO), DM / 32, 1 << 30, 0, scr, r, F.lane); continue; } r -= I_O;
        p0_transpose_item(F.in[17], DM, DM, (hbf*)(F.ws + WS_WPQ), DM / 32, 1 << 30, 0, scr, r, F.lane, F.in[16]);
    }
}
__device__ __forceinline__ void phase0(const Frame& F) {
    LAS float* Wf = (LAS float*)F.lds;
    for (int k = F.tid; k < DM; k += NTHREADS) {
        const f32x4 a = *(const f32x4*)(F.in[6] + (size_t)k * INW + 3 * FW), b = *(const f32x4*)(F.in[6] + (size_t)k * INW + 3 * FW + 4);
        Wf[0 * DM + k] = a[0]; Wf[1 * DM + k] = a[1]; Wf[2 * DM + k] = a[2]; Wf[3 * DM + k] = a[3];
        Wf[4 * DM + k] = b[0]; Wf[5 * DM + k] = b[1]; Wf[6 * DM + k] = b[2]; Wf[7 * DM + k] = b[3];
    }
    __syncthreads();
    const int gw = F.vcu * NWAVES + F.wave, NGW = F.G * NWAVES;
    hbf* H = (hbf*)(F.ws + WS_H);
    for (int m = gw; m < MT; m += NGW) {
        const f32x4* xr = (const f32x4*)xrow(F, m) + F.lane;
        f32x4 v[8]; float ss = 0.f;
#pragma unroll
        for (int j = 0; j < 8; ++j) { v[j] = xr[64 * j]; ss += (v[j][0] * v[j][0] + v[j][1] * v[j][1]) + (v[j][2] * v[j][2] + v[j][3] * v[j][3]); }
        const float rstd = 1.0f / sqrtf(wave_sum_dpp(ss) * (1.0f / DM) + EPS);
        float fl[8];
#pragma unroll
        for (int q = 0; q < 8; ++q) fl[q] = 0.f;
#pragma unroll
        for (int j = 0; j < 8; ++j) {
            const f32x4 g = ((const f32x4*)F.in[5])[64 * j + F.lane];
            v[j] = v[j] * rstd;
            v2u o; o.x = pk2(v[j][0], v[j][1]); o.y = pk2(v[j][2], v[j][3]);
            *(v2u*)(H + (size_t)m * DM + 4 * (64 * j + F.lane)) = o;
            v[j] = v[j] * g;
#pragma unroll
            for (int q = 0; q < 8; ++q) { const f32x4 w = *(const LAS f32x4*)(Wf + q * DM + 4 * (64 * j + F.lane)); fl[q] += (v[j][0] * w[0] + v[j][1] * w[1]) + (v[j][2] * w[2] + v[j][3] * w[3]); }
        }
        float mine = 0.f;
#pragma unroll
        for (int q = 0; q < 8; ++q) { const float s = wave_sum_dpp(fl[q]); if (F.lane == q) mine = s; }
        if (F.lane < 8) { if (F.lane == 0) ((float*)(F.ws + WS_RS0))[m] = 1.0f / rstd;
            const float lf = log_sigmoid(mine + F.in[7][F.lane]);
            if (m < MP) F.out[O_LFP + (size_t)m * FH + F.lane] = lf; else F.out[O_LFS + (size_t)(m - MP) * FH + F.lane] = lf; }
    }
    LAS float* scr = (LAS float*)(F.lds + 65536 + F.wave * 8448);
    for (int it = gw + (MT - gw + NGW - 1) / NGW * NGW - MT; it < P0_I_IN; it += NGW) p0_transpose_item(F.in[6], INW, DM, (hbf*)(F.ws + WS_WIN), NZ / 32, 3 * FW, 8, scr, it, F.lane, F.in[5]);
    if (!P0_LATE_OK(F)) late_weights(F, scr, gw, NGW);
    const size_t gt = (size_t)F.vcu * NTHREADS + F.tid, NGT = (size_t)F.G * NTHREADS;
    for (size_t i = gt; i < (size_t)PEH * 2 * PEK * 128 / 8; i += NGT) cvt8(F.in[19], (hbf*)(F.ws + WS_SK), i);
    for (size_t i = gt; i < (size_t)SGG * SGC * SGC / 8; i += NGT) {
        const int row = (int)((i * 8) / SGC) % SGC, c0 = (int)((i * 8) % SGC);
        const f32x4 a = *(const f32x4*)(F.in[11] + i * 8), b = *(const f32x4*)(F.in[11] + i * 8 + 4);
        float t[8] = {a[0], a[1], a[2], a[3], b[0], b[1], b[2], b[3]};
#pragma unroll
        for (int e = 0; e < 8; ++e) if (c0 + e > row) t[e] = 0.f;
        v4u o; o.x = pk2(t[0], t[1]); o.y = pk2(t[2], t[3]); o.z = pk2(t[4], t[5]); o.w = pk2(t[6], t[7]);
        *(v4u*)((hbf*)(F.ws + WS_WSP) + i * 8) = o;
    }
}

__device__ __forceinline__ void convert_tables(const Frame& F, int rank, int nranks, size_t lo = 0, size_t hi = (size_t)NEXP * DM / 32) {
    const size_t gt = (size_t)rank * NTHREADS + F.tid, NGT = (size_t)nranks * NTHREADS;
    for (size_t i = lo + gt; i < hi; i += NGT) { cvt32_fp4(F.in[20], F.ws + WS_TU, i, 64.f); cvt32_fp4(F.in[21], F.ws + WS_TV, i, 16.f); }
}
constexpr int CW_CV = 6400, CW_P7 = 6464, CV_CHUNK = 1024;
__device__ __forceinline__ void convert_tables_dyn(const Frame& F, size_t lo) {
    constexpr size_t HI = (size_t)NEXP * DM / 32;
    LAS int* slot = (LAS int*)(F.lds + 64);
    unsigned* ctr = (unsigned*)(F.ws + WS_CTL) + CW_CV;
    __syncthreads();
    if (F.tid == 0) slot[0] = (int)atomicAdd(ctr, 1u);
    __syncthreads();
    int c = __builtin_amdgcn_readfirstlane(slot[0]), par = 1;
    while (lo + (size_t)c * CV_CHUNK < HI) {
        unsigned nx = 0; if (F.tid == 0) nx = atomicAdd(ctr, 1u);
        const size_t base = lo + (size_t)c * CV_CHUNK;
#pragma unroll
        for (int k = 0; k < CV_CHUNK / NTHREADS; ++k) { const size_t i = base + k * NTHREADS + F.tid; if (i < HI) { cvt32_fp4(F.in[20], F.ws + WS_TU, i, 64.f); cvt32_fp4(F.in[21], F.ws + WS_TV, i, 16.f); } }
        if (F.tid == 0) slot[par] = (int)nx;
        __syncthreads();
        c = __builtin_amdgcn_readfirstlane(slot[par]); par ^= 1;
    }
}
__device__ __forceinline__ void phase1_scan(const Frame& F, int unit) {
    LAS float* part = (LAS float*)F.lds;
    const int h = F.tid & 7, ch = F.tid >> 3;
    if (unit < NBATCH) {
        const float* lf = F.out + O_LFP + (size_t)unit * SEQ * FH;
        float* pb = (float*)(F.ws + WS_PB) + ((size_t)unit * FH + h) * SEQ;
        float s = 0.f;
        for (int i = 0; i < 128; ++i) s += lf[(size_t)(ch * 128 + i) * FH + h];
        part[ch * 8 + h] = s; __syncthreads();
        float base = 0.f; for (int c = 0; c < ch; ++c) base += part[c * 8 + h];
        constexpr float INV = 11.313708498984761f;
        for (int i = 0; i < 128; ++i) { base += lf[(size_t)(ch * 128 + i) * FH + h]; pb[ch * 128 + i] = -base * INV; }
        __syncthreads();
    } else {
        const int bb = unit - NBATCH;
        const float* lf = F.in[4] + (size_t)bb * PAST * FH;
        float* sb = (float*)(F.ws + WS_SB) + ((size_t)bb * FH + h) * SBP;
        float s = 0.f;
        for (int i = 0; i < 64; ++i) s += lf[(size_t)(ch * 64 + i) * FH + h];
        part[ch * 8 + h] = s; __syncthreads();
        float suf = 0.f; for (int c = ch + 1; c < 64; ++c) suf += part[c * 8 + h];
        for (int i = 63; i >= 0; --i) { sb[ch * 64 + i] = suf; suf += lf[(size_t)(ch * 64 + i) * FH + h]; }
        if (ch == 0) { const float* ln = F.out + O_LFS + (size_t)bb * DSEQ * FH; float a = 0.f;
            for (int i = 0; i < DSEQ; ++i) { a += ln[i * FH + h]; sb[PAST + i] = -a; }
            for (int i = DSEQ; i < SBP - PAST; ++i) sb[PAST + i] = 0.f; }
        __syncthreads();
    }
}
#define XB_TMO      128
#define XB_XCNT(j)  (256  + 64 * (j))
#define XB_XSUB(j)  (1280 + 64 * (j))
#define XB_XGEN(j)  (2304 + 64 * (j))
#define XB_TOP      3328
#define XB_TOPGEN   3392
#define XCD_BAR_WORDS 3456
#define XB_SPIN_CAP (1u << 18)

__device__ __forceinline__ unsigned xb_ld(unsigned* p)              { return __hip_atomic_load(p, __ATOMIC_RELAXED, __HIP_MEMORY_SCOPE_AGENT); }
__device__ __forceinline__ unsigned xb_add(unsigned* p, unsigned v) { return __hip_atomic_fetch_add(p, v, __ATOMIC_RELAXED, __HIP_MEMORY_SCOPE_AGENT); }
__device__ __forceinline__ unsigned xb_xcc_id() { return (unsigned)__builtin_amdgcn_s_getreg((3 << 11) | 20) & 0xFu; }
#define XB_SPIN(cond, bar) do { unsigned _sp = 0; while (cond) { __builtin_amdgcn_s_sleep(1); \
    if ((++_sp & 255u) == 0u) { if (xb_ld(&(bar)[XB_TMO])) break; if (_sp > XB_SPIN_CAP) { atomicAdd(&(bar)[XB_TMO], 1u); break; } } } } while (0)

struct XcdBarrier {
    unsigned* bar; unsigned x;
    volatile LAS unsigned* st;
};

__device__ __forceinline__ XcdBarrier xcd_barrier_post(unsigned* bar, volatile LAS unsigned* st) {
    XcdBarrier b; b.bar = bar; b.x = xb_xcc_id(); b.st = st;
    if (threadIdx.x == 0) (void)xb_add(&bar[XB_XCNT(b.x)], 1u);
    return b;
}
__device__ __forceinline__ void xcd_barrier_complete(unsigned* bar, unsigned x, unsigned& nloc, unsigned& nx) {
    const unsigned G = gridDim.x * gridDim.y * gridDim.z;
    unsigned sum, cnt, mine, sp = 0u;
    for (;;) {
        sum = 0u; cnt = 0u; mine = 0u;
#pragma unroll
        for (unsigned j = 0; j < 16; ++j) { const unsigned c = xb_ld(&bar[XB_XCNT(j)]); sum += c; cnt += (c > 0u) ? 1u : 0u; mine = (j == x) ? c : mine; }
        if (sum == G) break;
        __builtin_amdgcn_s_sleep(1);
        if ((++sp & 255u) == 0u) { if (xb_ld(&bar[XB_TMO])) break; if (sp > XB_SPIN_CAP) { atomicAdd(&bar[XB_TMO], 1u); break; } }
    }
    nloc = mine > 0u ? mine : 1u; nx = cnt > 0u ? cnt : 1u;
}

__device__ __forceinline__ void xcd_barrier(const XcdBarrier& b) {
    asm volatile("s_waitcnt vmcnt(0)" ::: "memory");
    __syncthreads();
    if (threadIdx.x == 0) {
        unsigned* bar = b.bar;
        __builtin_amdgcn_s_waitcnt(0);
        unsigned nloc = b.st[0], nx = b.st[1];
        if (nloc == 0u) { xcd_barrier_complete(bar, b.x, nloc, nx); b.st[0] = nloc; b.st[1] = nx; }
        const unsigned old = xb_add(&bar[XB_XSUB(b.x)], 1u);
        const unsigned gen = old / nloc;
        if (old + 1u == (gen + 1u) * nloc) {
            __builtin_amdgcn_fence(__ATOMIC_RELEASE, "agent");
            asm volatile("s_waitcnt vmcnt(0)" ::: "memory");
            const unsigned og = xb_add(&bar[XB_TOP], 1u);
            const unsigned tg = og / nx;
            if (og + 1u == (tg + 1u) * nx) xb_add(&bar[XB_TOPGEN], 1u);
            else XB_SPIN(xb_ld(&bar[XB_TOPGEN]) == tg, bar);
            __builtin_amdgcn_fence(__ATOMIC_ACQUIRE, "agent");
            xb_add(&bar[XB_XGEN(b.x)], 1u);
            asm volatile("s_waitcnt vmcnt(0)" ::: "memory");
        } else {
            XB_SPIN(xb_ld(&bar[XB_XGEN(b.x)]) == gen, bar);
            __builtin_amdgcn_fence(__ATOMIC_ACQUIRE, "agent");
            asm volatile("s_waitcnt vmcnt(0)" ::: "memory");
        }
    }
    __syncthreads();
}

__device__ __forceinline__ void chain_barrier(unsigned* cnt, unsigned k) {
    asm volatile("s_waitcnt vmcnt(0)" ::: "memory");
    __syncthreads();
    if (threadIdx.x == 0) {
        __builtin_amdgcn_fence(__ATOMIC_RELEASE, "agent");
        asm volatile("s_waitcnt vmcnt(0)" ::: "memory");
        (void)xb_add(cnt, 1u);
        const unsigned want = (unsigned)NCHAIN * (k + 1u); unsigned sp = 0u;
        while (xb_ld(cnt) < want) { __builtin_amdgcn_s_sleep(1); if (++sp > (1u << 22)) break; }
        __builtin_amdgcn_fence(__ATOMIC_ACQUIRE, "agent");
        asm volatile("s_waitcnt vmcnt(0)" ::: "memory");
    }
    __syncthreads();
}
#define EPI_BAR() do { asm volatile("s_waitcnt lgkmcnt(0)" ::: "memory"); __builtin_amdgcn_s_barrier(); asm volatile("" ::: "memory"); } while (0)
__device__ __forceinline__ v4u pack8f(const float* v) { v4u o; o.x = pk2(v[0], v[1]); o.y = pk2(v[2], v[3]); o.z = pk2(v[4], v[5]); o.w = pk2(v[6], v[7]); return o; }

struct EpiIn {
    static constexpr bool PERM = true, AFTER_DRAIN = false;
    hbf *Qp, *Qs, *Kp, *Vp, *US, *VS, *GA, *GB; float* out; float* VSSQ; const float *qg, *kg; LAS float* P; int noepi = 0;
    __device__ __forceinline__ void operator()(const pg8::f32x4 (&acc)[2][2][4][2], const pg8::Unit& u, int wr, int wc, int fr, int fq) const {
#ifdef PROBE_NOEPI
        if (noepi) return;
#endif
        const int pn = u.pn, sec = pn < 20 ? (pn >> 2) : (pn < 28 ? 5 : 6);
        const bool sample = (u.pm == NTM - 1);
        if (sec <= 1) {
#pragma unroll
            for (int ai = 0; ai < 2; ++ai)
#pragma unroll
                for (int m = 0; m < 4; ++m)
#pragma unroll
                    for (int bj = 0; bj < 2; ++bj) {
                        const f32x4 a = acc[ai][bj][m][0], b = acc[ai][bj][m][1];
                        float s = (a[0] * a[0] + a[1] * a[1]) + (a[2] * a[2] + a[3] * a[3]) + (b[0] * b[0] + b[1] * b[1]) + (b[2] * b[2] + b[3] * b[3]);
                        s += __shfl_xor(s, 16); s += __shfl_xor(s, 32);
                        const int rl = ai * 128 + wr * 64 + m * 16 + fr;
                        if (fq == 0) P[(rl * 2 + bj) * 4 + wc] = s;
                        asm volatile("" ::: "memory");
                    }
            EPI_BAR();
            const float* gsrc = (sec == 0 ? qg : kg) + wc * 32 + 8 * fq;
            const f32x4 g0 = *(const f32x4*)gsrc, g1 = *(const f32x4*)(gsrc + 4);
#pragma unroll
            for (int ai = 0; ai < 2; ++ai)
#pragma unroll
                for (int m = 0; m < 4; ++m) {
                    const int rl = ai * 128 + wr * 64 + m * 16 + fr, tok = u.pm * 256 + rl;
#pragma unroll
                    for (int bj = 0; bj < 2; ++bj) {
                        const f32x4 p4 = *(const LAS f32x4*)(P + (rl * 2 + bj) * 4);
                        const float rstd = 1.0f / sqrtf(((p4[0] + p4[1]) + (p4[2] + p4[3])) * (1.0f / FD) + EPS);
                        const f32x4 a = acc[ai][bj][m][0] * rstd * g0, b = acc[ai][bj][m][1] * rstd * g1;
                        const float v[8] = {a[0], a[1], a[2], a[3], b[0], b[1], b[2], b[3]};
                        const int head = (pn & 3) * 2 + bj, d0 = wc * 32 + 8 * fq;
                        if (sec == 0) {
                            hbf* dst = sample ? Qs + ((size_t)(((tok - MP) >> 4) * FH + head) * DSEQ + ((tok - MP) & 15)) * FD + d0
                                              : Qp + ((size_t)((tok >> 13) * FH + head) * SEQ + (tok & (SEQ - 1))) * FD + d0;
                            *(v4u*)dst = pack8f(v);
                        } else {
                            float* o = sample ? out + O_KS + (size_t)(tok - MP) * FW + head * FD + d0 : out + O_KP + (size_t)tok * FW + head * FD + d0;
                            *(f32x4*)o = a; *(f32x4*)(o + 4) = b;
                            if (!sample) *(v4u*)(Kp + ((size_t)((tok >> 13) * FH + head) * SEQ + (tok & (SEQ - 1))) * FD + d0) = pack8f(v);
                        }
                    }
                    asm volatile("" ::: "memory");
                }
        } else if (sec == 2) {
#pragma unroll
            for (int ai = 0; ai < 2; ++ai)
#pragma unroll
                for (int m = 0; m < 4; ++m) {
                    const int rl = ai * 128 + wr * 64 + m * 16 + fr, tok = u.pm * 256 + rl;
#pragma unroll
                    for (int bj = 0; bj < 2; ++bj) {
                        const f32x4 a = acc[ai][bj][m][0], b = acc[ai][bj][m][1];
                        const float v[8] = {a[0], a[1], a[2], a[3], b[0], b[1], b[2], b[3]};
                        const int head = (pn & 3) * 2 + bj, d0 = wc * 32 + 8 * fq;
                        float* o = sample ? out + O_VS + (size_t)(tok - MP) * FW + head * FD + d0 : out + O_VP + (size_t)tok * FW + head * FD + d0;
                        *(f32x4*)o = a; *(f32x4*)(o + 4) = b;
                        if (!sample) *(v4u*)(Vp + ((size_t)((tok >> 13) * FH + head) * SEQ + (tok & (SEQ - 1))) * FD + d0) = pack8f(v);
                    }
                }
        } else if (sec == 3 || sec == 4) {
            hbf* dstb = sec == 3 ? US : VS;
#pragma unroll
            for (int ai = 0; ai < 2; ++ai)
#pragma unroll
                for (int m = 0; m < 4; ++m) {
                    const int rl = ai * 128 + wr * 64 + m * 16 + fr, tok = u.pm * 256 + rl;
                    float ss = 0.f;
#pragma unroll
                    for (int bj = 0; bj < 2; ++bj) {
                        float v[8];
#pragma unroll
                        for (int e = 0; e < 4; ++e) { v[e] = gelu_tanh(acc[ai][bj][m][0][e]); v[4 + e] = gelu_tanh(acc[ai][bj][m][1][e]); }
#pragma unroll
                        for (int e = 0; e < 8; ++e) ss += v[e] * v[e];
                        *(v4u*)(dstb + (size_t)tok * SGW + (pn & 3) * 256 + bj * 128 + wc * 32 + 8 * fq) = pack8f(v);
                    }
                    if (sec == 4) { ss += __shfl_xor(ss, 16); ss += __shfl_xor(ss, 32); if (fq == 0) VSSQ[(size_t)tok * 16 + (pn & 3) * 4 + wc] = ss; }
                }
        } else {
            hbf* dstb = sec == 5 ? GA : GB; const int c0 = (sec == 5 ? pn - 20 : pn - 28) * 256;
#pragma unroll
            for (int ai = 0; ai < 2; ++ai)
#pragma unroll
                for (int m = 0; m < 4; ++m) {
                    const int rl = ai * 128 + wr * 64 + m * 16 + fr, tok = u.pm * 256 + rl;
#pragma unroll
                    for (int bj = 0; bj < 2; ++bj) {
                        float v[8];
#pragma unroll
                        for (int e = 0; e < 4; ++e) { v[e] = sigmoidf_(acc[ai][bj][m][0][e]); v[4 + e] = sigmoidf_(acc[ai][bj][m][1][e]); }
                        *(v4u*)(dstb + (size_t)tok * DM + c0 + bj * 128 + wc * 32 + 8 * fq) = pack8f(v);
                    }
                }
        }
    }
};

struct MergeOrder {
    int G, c, lo, hi;
    __device__ __forceinline__ bool next(int i, pg8::Unit& u) const {
        const int t = lo + (i >> 1) * G + c; if (t >= hi) return false;
        u.pm = t >> 3; u.pn = t & 7; if (i & 1) { u.pm += NTM; u.pn += 8; } return true;
    }
    __device__ __forceinline__ void a_ready(const pg8::Unit&) const {}
    __device__ __forceinline__ void done(const pg8::Unit&) const {}
};
struct OneTile {
    int pm, pn;
    __device__ __forceinline__ bool next(int i, pg8::Unit& u) const { if (i > 0) return false; u.pm = pm; u.pn = pn; return true; }
    __device__ __forceinline__ void a_ready(const pg8::Unit&) const {}
    __device__ __forceinline__ void done(const pg8::Unit&) const {}
};
struct TileOrder {
    pg8::StaticOrder so; bool chain; int ci;
    __device__ __forceinline__ bool next(int i, pg8::Unit& u) const {
        if (!chain) return so.next(i, u);
        if (i > 0) return false; u.pm = NTM - 1; u.pn = ci; return true;
    }
    __device__ __forceinline__ void a_ready(const pg8::Unit&) const {}
    __device__ __forceinline__ void done(const pg8::Unit&) const {}
};
struct EpiMerge {
    static constexpr bool PERM = true, AFTER_DRAIN = false;
    const hbf *GA, *GB; hbf* Y;
    __device__ __forceinline__ void operator()(const pg8::f32x4 (&acc)[2][2][4][2], const pg8::Unit& u, int wr, int wc, int fr, int fq) const {
        const bool isb = u.pn >= 8; const int pm = isb ? u.pm - NTM : u.pm, pn = u.pn & 7; const hbf* G = isb ? GB : GA;
#pragma unroll
        for (int ai = 0; ai < 2; ++ai)
#pragma unroll
            for (int m = 0; m < 4; ++m) {
                const int tok = pm * 256 + ai * 128 + wr * 64 + m * 16 + fr;
#pragma unroll
                for (int bj = 0; bj < 2; ++bj) {
                    const size_t off = (size_t)tok * DM + pn * 256 + bj * 128 + wc * 32 + 8 * fq;
                    const v4u g = *(const v4u*)(G + off);
                    const f32x4 a = acc[ai][bj][m][0], b = acc[ai][bj][m][1];
                    float v[8] = {a[0] * bflo(g.x), a[1] * bfhi(g.x), a[2] * bflo(g.y), a[3] * bfhi(g.y), b[0] * bflo(g.z), b[1] * bfhi(g.z), b[2] * bflo(g.w), b[3] * bfhi(g.w)};
                    if (isb) { const v4u y = *(const v4u*)(Y + off);
                        v[0] += bflo(y.x); v[1] += bfhi(y.x); v[2] += bflo(y.y); v[3] += bfhi(y.y); v[4] += bflo(y.z); v[5] += bfhi(y.z); v[6] += bflo(y.w); v[7] += bfhi(y.w); }
                    *(v4u*)(Y + off) = pack8f(v);
                }
            }
    }
};

struct EpiOut {
    static constexpr bool PERM = true, AFTER_DRAIN = false;
    const hbf* XH; const float* RMS; hbf* XB; float* XSSQ;
    __device__ __forceinline__ void operator()(const pg8::f32x4 (&acc)[2][2][4][2], const pg8::Unit& u, int wr, int wc, int fr, int fq) const {
#pragma unroll
        for (int ai = 0; ai < 2; ++ai)
#pragma unroll
            for (int m = 0; m < 4; ++m) {
                const int tok = u.pm * 256 + ai * 128 + wr * 64 + m * 16 + fr;
                float ss = 0.f; const float rms = RMS[tok];
#pragma unroll
                for (int bj = 0; bj < 2; ++bj) {
                    const int col = u.pn * 256 + bj * 128 + wc * 32 + 8 * fq;
                    const v4u xh = *(const v4u*)(XH + (size_t)tok * DM + col);
                    const f32x4 a = acc[ai][bj][m][0] + (f32x4){bflo(xh.x), bfhi(xh.x), bflo(xh.y), bfhi(xh.y)} * rms, b = acc[ai][bj][m][1] + (f32x4){bflo(xh.z), bfhi(xh.z), bflo(xh.w), bfhi(xh.w)} * rms;
                    ss += (a[0] * a[0] + a[1] * a[1]) + (a[2] * a[2] + a[3] * a[3]) + (b[0] * b[0] + b[1] * b[1]) + (b[2] * b[2] + b[3] * b[3]);
                    const float v[8] = {a[0], a[1], a[2], a[3], b[0], b[1], b[2], b[3]};
                    *(v4u*)(XB + (size_t)tok * DM + col) = pack8f(v);
                }
                ss += __shfl_xor(ss, 16); ss += __shfl_xor(ss, 32);
                if (fq == 0) XSSQ[(size_t)tok * 32 + u.pn * 4 + wc] = ss;
            }
    }
};

struct EpiPeerQ {
    static constexpr bool PERM = true, AFTER_DRAIN = false;
    const float* XSSQ; const float* pqg; hbf* QN; LAS float* P;
    __device__ __forceinline__ void operator()(const pg8::f32x4 (&acc)[2][2][4][2], const pg8::Unit& u, int wr, int wc, int fr, int fq) const {
        LAS float* R = P + 2048;
        const int tid = threadIdx.x;
        if (tid < 256) { const f32x4* s = (const f32x4*)(XSSQ + (size_t)(u.pm * 256 + tid) * 32); float t = 0.f;
#pragma unroll
            for (int k = 0; k < 8; ++k) { const f32x4 q = s[k]; t += (q[0] + q[1]) + (q[2] + q[3]); }
            R[tid] = 1.0f / sqrtf(t * (1.0f / DM) + EPS); }
#pragma unroll
        for (int ai = 0; ai < 2; ++ai)
#pragma unroll
            for (int m = 0; m < 4; ++m)
#pragma unroll
                for (int bj = 0; bj < 2; ++bj) {
                    const f32x4 a = acc[ai][bj][m][0], b = acc[ai][bj][m][1];
                    float s = (a[0] * a[0] + a[1] * a[1]) + (a[2] * a[2] + a[3] * a[3]) + (b[0] * b[0] + b[1] * b[1]) + (b[2] * b[2] + b[3] * b[3]);
                    s += __shfl_xor(s, 16); s += __shfl_xor(s, 32);
                    const int rl = ai * 128 + wr * 64 + m * 16 + fr;
                    if (fq == 0) P[rl * 8 + bj * 4 + wc] = s;
                    asm volatile("" ::: "memory");
                }
        EPI_BAR();
#pragma unroll
        for (int ai = 0; ai < 2; ++ai)
#pragma unroll
            for (int m = 0; m < 4; ++m) {
                const int rl = ai * 128 + wr * 64 + m * 16 + fr, tok = u.pm * 256 + rl;
                const f32x4 p0 = *(const LAS f32x4*)(P + rl * 8), p1 = *(const LAS f32x4*)(P + rl * 8 + 4);
                const float rx = R[rl];
                const float ssq = ((p0[0] + p0[1]) + (p0[2] + p0[3]) + (p1[0] + p1[1]) + (p1[2] + p1[3])) * rx * rx;
                const float sc = rx / sqrtf(ssq * (1.0f / PED) + EPS);
#pragma unroll
                for (int bj = 0; bj < 2; ++bj) {
                    const int d0 = bj * 128 + wc * 32 + 8 * fq;
                    const f32x4 g0 = *(const f32x4*)(pqg + d0), g1 = *(const f32x4*)(pqg + d0 + 4);
                    const f32x4 a = acc[ai][bj][m][0] * sc * g0, b = acc[ai][bj][m][1] * sc * g1;
                    const float v[8] = {a[0], a[1], a[2], a[3], b[0], b[1], b[2], b[3]};
                    *(v4u*)(QN + (size_t)tok * DM + u.pn * PED + d0) = pack8f(v);
                }
                asm volatile("" ::: "memory");
            }
    }
};
#define MFMA16(a, b, c) __builtin_amdgcn_mfma_f32_16x16x32_bf16((a), (b), (c), 0, 0, 0)
#define MFMA32(a, b, c) __builtin_amdgcn_mfma_f32_32x32x16_bf16((a), (b), (c), 0, 0, 0)
constexpr int ATT_BIAS_OFF = 69632;

constexpr int Q_SAMPLE = DBATCH * FH, Q_PROMPT = NBATCH * FH * (SEQ / 256), Q_SGS = Q_SAMPLE + Q_PROMPT, Q_SGP = Q_SGS + DBATCH * 8, Q_SGU = DBATCH * 8 + 1024, Q_END = Q_SGP + 1024;
#ifndef DECAY_SKIP
#define DECAY_SKIP 1
#endif
constexpr int CW_Q = 6144;
constexpr int LDS_POP = LDS_BYTES - 128, LDS_MX = LDS_BYTES - 256;
__device__ __forceinline__ int p2_pop(const Frame& F) {
    LAS int* slot = (LAS int*)(F.lds + LDS_POP);
    __syncthreads();
    if (F.tid == 0) *slot = (int)atomicAdd((unsigned*)(F.ws + WS_CTL) + CW_Q, 1u);
    __syncthreads();
    return __builtin_amdgcn_readfirstlane(*slot);
}
__device__ __forceinline__ float attn_skip_threshold(const Frame& F) {
    LAS unsigned* mx = (LAS unsigned*)(F.lds + LDS_MX);
    __syncthreads();
    if (F.tid < 2) mx[F.tid] = 0u;
    __syncthreads();
    if (F.tid < FD) { atomicMax((unsigned*)(mx + 0), __float_as_uint(fabsf(F.in[8][F.tid]))); atomicMax((unsigned*)(mx + 1), __float_as_uint(fabsf(F.in[9][F.tid]))); }
    __syncthreads();
    const float sb = 11.313708498984761f * __uint_as_float(mx[0]) * __uint_as_float(mx[1]) * 1.01f;
    const float tv = -(88.0f + 2.0f * sb) * 11.313708498984761f; float ts;
    if (F.tid == 0) ((LAS float*)mx)[2] = tv;
    asm volatile("v_readfirstlane_b32 %0, %1" : "=s"(ts) : "v"(tv));
    return ts;
}
__device__ __forceinline__ attn::BlockRef<attn::bf16, attn::bf16> attn_prompt_ref(const Frame& F, int idx, float thr_raw  ) {
    using namespace attn;
    const int qb = 31 - (idx >> 4), bh = idx & 15, P0 = qb * QB;
    const float* pb = (const float*)(F.ws + WS_PB) + (size_t)bh * SEQ;
    float* bias_lds = (float*)((char*)F.lds_g + ATT_BIAS_OFF);
    int t_ = threadIdx.x; asm volatile("" : "+v"(t_));
    for (int i = t_; i < (P0 + 256) / 4; i += NTHREADS) *(f32x4*)(bias_lds + 4 * i) = *(const f32x4*)(pb + 4 * i);
    __syncthreads();
    const float p0v = bias_lds[P0];
    thr_raw = ((LAS float*)(F.lds + LDS_MX))[2];
    const int l_ = t_ & 63, nt_ = P0 / KVBLK;
    const bool s_lo = (l_ < nt_) && (bias_lds[KVBLK * l_ + KVBLK - 1] - p0v < thr_raw);
    const bool s_hi = (l_ + 64 < nt_) && (bias_lds[KVBLK * (l_ + 64) + KVBLK - 1] - p0v < thr_raw);
    const unsigned long long b_lo = __ballot(s_lo), b_hi = __ballot(s_hi);
    const int run_lo = (~b_lo == 0ull) ? 64 : (int)__builtin_ctzll(~b_lo), run_hi = (~b_hi == 0ull) ? 64 : (int)__builtin_ctzll(~b_hi);
    const int jlo = __builtin_amdgcn_readfirstlane(run_lo < 64 ? run_lo : 64 + run_hi);
    BlockRef<bf16, bf16> r;
    r.Q = (const bf16*)(F.ws + WS_Q) + ((size_t)bh * SEQ + P0) * D; r.K = (const bf16*)(F.ws + WS_K) + (size_t)bh * SEQ * D; r.V = (const bf16*)(F.ws + WS_V) + (size_t)bh * SEQ * D;
    r.O = (bf16*)(F.ws + WS_OA) + ((size_t)(bh >> 3) * SEQ + P0) * OSTR + (bh & 7) * D; r.P0 = P0; r.jlo = jlo;
    return r;
}

__device__ __forceinline__ bf16x8 packf8(f32x4 a, f32x4 b) { v4u w; w.x = pk2(a[0], a[1]); w.y = pk2(a[2], a[3]); w.z = pk2(b[0], b[1]); w.w = pk2(b[2], b[3]); return __builtin_bit_cast(bf16x8, w); }
__device__ __forceinline__ void attn_sample_unit(const Frame& F, int unit) {
    int tid_ = threadIdx.x; asm volatile("" : "+v"(tid_)); const int lane_ = tid_ & 63;
    const int bb = unit >> 3, h = unit & 7, r = lane_ & 15, g = lane_ >> 4;
    const hbf* qrow = (const hbf*)(F.ws + WS_QS) + ((size_t)(bb * FH + h) * DSEQ + r) * FD;
    bf16x8 qf[4];
#pragma unroll
    for (int ks = 0; ks < 4; ++ks) { const v2u lo = *(const v2u*)(qrow + 32 * ks + 4 * g), hi = *(const v2u*)(qrow + 32 * ks + 16 + 4 * g);
        v4u w; w.x = lo.x; w.y = lo.y; w.z = hi.x; w.w = hi.y; qf[ks] = __builtin_bit_cast(bf16x8, w); }
    float mrun = -1e30f, lrun = 0.f; f32x4 o[2][4];
#pragma unroll
    for (int a = 0; a < 2; ++a)
#pragma unroll
        for (int b = 0; b < 4; ++b) o[a][b] = (f32x4){0.f, 0.f, 0.f, 0.f};
    const float* kc = F.in[2] + ((size_t)bb * PAST * FH + h) * FD;
    const float* vc = F.in[3] + ((size_t)bb * PAST * FH + h) * FD;
    const float* kn = F.out + O_KS + ((size_t)bb * DSEQ * FH + h) * FD;
    const float* vn = F.out + O_VS + ((size_t)bb * DSEQ * FH + h) * FD;
    const float* sb = (const float*)(F.ws + WS_SB) + (size_t)(bb * FH + h) * SBP;
    constexpr float C2 = 0.08838834764831845f * LOG2E;
    bool spec = true;
    f32x4 kv[2][4][2], vv[2][8];
#define SA_LOADK(t_) do { const bool nw_ = ((t_) == 128); const float* kb_ = nw_ ? kn : kc + (size_t)(t_) * 32 * FW; \
        _Pragma("unroll") for (int kb = 0; kb < 2; ++kb) { int key = 16 * kb + r; if (nw_ && key > 15) key = 15; \
            _Pragma("unroll") for (int ks = 0; ks < 4; ++ks) _Pragma("unroll") for (int i = 0; i < 2; ++i) kv[kb][ks][i] = *(const f32x4*)(kb_ + (size_t)key * FW + 32 * ks + 16 * i + 4 * g); } } while (0)
#define SA_LOADV(t_) do { const bool nw_ = ((t_) == 128); const float* vb_ = nw_ ? vn : vc + (size_t)(t_) * 32 * FW; \
        _Pragma("unroll") for (int j = 0; j < 8; ++j) { int key = 16 * (j >> 2) + 4 * g + (j & 3); if (nw_ && key > 15) key = 15; \
            _Pragma("unroll") for (int grp = 0; grp < 2; ++grp) vv[grp][j] = *(const f32x4*)(vb_ + (size_t)key * FW + 64 * grp + 4 * r); } } while (0)
#pragma unroll 1
    for (int t = 128 - F.wave; t >= 0; t -= NWAVES) {
        const bool isnew = (t == 128), near = spec;
        SA_LOADK(t);
        if (near) SA_LOADV(t);
        const f32x4 bs0 = *(const f32x4*)(sb + t * 32 + 4 * g), bs1 = *(const f32x4*)(sb + t * 32 + 16 + 4 * g);
        f32x4 s0 = {0.f, 0.f, 0.f, 0.f}, s1 = {0.f, 0.f, 0.f, 0.f};
#pragma unroll
        for (int ks = 0; ks < 4; ++ks) { s0 = MFMA16(packf8(kv[0][ks][0], kv[0][ks][1]), qf[ks], s0); s1 = MFMA16(packf8(kv[1][ks][0], kv[1][ks][1]), qf[ks], s1); }
        float x[8];
#pragma unroll
        for (int i = 0; i < 4; ++i) { x[i] = s0[i] * C2 + bs0[i] * LOG2E; x[4 + i] = s1[i] * C2 + bs1[i] * LOG2E; }
        if (isnew) {
#pragma unroll
            for (int i = 0; i < 4; ++i) { if (4 * g + i > r) x[i] = -__builtin_inff(); x[4 + i] = -__builtin_inff(); }
        }
        float mx = fmaxf(fmaxf(fmaxf(x[0], x[1]), fmaxf(x[2], x[3])), fmaxf(fmaxf(x[4], x[5]), fmaxf(x[6], x[7])));
        if (__all(mx <= mrun - 150.0f)) { spec = false; continue; }
        if (!near) SA_LOADV(t);
        mx = fmaxf(mx, __shfl_xor(mx, 16)); mx = fmaxf(mx, __shfl_xor(mx, 32));
        const float mn = fmaxf(mrun, mx), alpha = __builtin_amdgcn_exp2f(mrun - mn); mrun = mn;
        float ps = 0.f;
#pragma unroll
        for (int i = 0; i < 8; ++i) { x[i] = __builtin_amdgcn_exp2f(x[i] - mn); ps += x[i]; }
        lrun = lrun * alpha + ps;
        v4u pw; pw.x = pk2(x[0], x[1]); pw.y = pk2(x[2], x[3]); pw.z = pk2(x[4], x[5]); pw.w = pk2(x[6], x[7]);
        const bf16x8 pf = __builtin_bit_cast(bf16x8, pw);
#pragma unroll
        for (int grp = 0; grp < 2; ++grp)
#pragma unroll
            for (int ii = 0; ii < 4; ++ii) {
                v4u aw; aw.x = pk2(vv[grp][0][ii], vv[grp][1][ii]); aw.y = pk2(vv[grp][2][ii], vv[grp][3][ii]); aw.z = pk2(vv[grp][4][ii], vv[grp][5][ii]); aw.w = pk2(vv[grp][6][ii], vv[grp][7][ii]);
                o[grp][ii] = MFMA16(__builtin_bit_cast(bf16x8, aw), pf, o[grp][ii] * alpha);
            }
    }
#undef SA_LOADK
#undef SA_LOADV
    lrun += __shfl_xor(lrun, 16); lrun += __shfl_xor(lrun, 32);
    LAS float* Wm = (LAS float*)F.lds; LAS float* Wl = Wm + 128; LAS float* WO = (LAS float*)(F.lds + 1024);
    if (g == 0) { Wm[F.wave * 16 + r] = mrun; Wl[F.wave * 16 + r] = lrun; }
#pragma unroll
    for (int grp = 0; grp < 2; ++grp)
#pragma unroll
        for (int i = 0; i < 4; ++i) {
            const f32x4 w = {o[grp][0][i], o[grp][1][i], o[grp][2][i], o[grp][3][i]};
            *(LAS f32x4*)(WO + ((size_t)(F.wave * 16 + r) * FD + 64 * grp + 16 * g + 4 * i)) = w;
        }
    __syncthreads();
    {
        const int q = tid_ >> 5, d0 = (tid_ & 31) * 4;
        float ms = -1e30f;
#pragma unroll
        for (int w = 0; w < NWAVES; ++w) ms = fmaxf(ms, Wm[w * 16 + q]);
        float ls = 0.f; f32x4 acc = {0.f, 0.f, 0.f, 0.f};
#pragma unroll
        for (int w = 0; w < NWAVES; ++w) { const float sc = __builtin_amdgcn_exp2f(Wm[w * 16 + q] - ms); ls += Wl[w * 16 + q] * sc; acc += *(const LAS f32x4*)(WO + (size_t)(w * 16 + q) * FD + d0) * sc; }
        const float inv = 1.0f / ls;
        v2u ov; ov.x = pk2(acc[0] * inv, acc[1] * inv); ov.y = pk2(acc[2] * inv, acc[3] * inv);
        *(v2u*)((hbf*)(F.ws + WS_OA) + (size_t)(MP + bb * DSEQ + q) * FW + h * FD + d0) = ov;
    }
    __syncthreads();
}

constexpr int SGU_PT = 136;
__device__ __forceinline__ void sgu_prompt_unit(const Frame& F, int unit) {
    int tid_ = threadIdx.x; asm volatile("" : "+v"(tid_)); const int lane_ = tid_ & 63;
    const int g = unit & 7, bn = unit >> 3, tok0 = bn * SGC;
    LAS hbf* VtT = (LAS hbf*)F.lds;
    const hbf* VS = (const hbf*)(F.ws + WS_VS); const hbf* US = (const hbf*)(F.ws + WS_US); hbf* OB = (hbf*)(F.ws + WS_OB);
    {
        const int j = tid_ >> 2, pp = tid_ & 3, c0 = 32 * pp;
        const f32x4 q = *(const f32x4*)((const float*)(F.ws + WS_VSSQ) + (size_t)(tok0 + j) * 16 + 4 * pp);
        float t = (q[0] + q[1]) + (q[2] + q[3]); t += __shfl_xor(t, 1); t += __shfl_xor(t, 2);
        const float r_ = 1.0f / sqrtf(t * (1.0f / SGW) + EPS);
        const hbf* src = VS + (size_t)(tok0 + j) * SGW + g * SGC + c0; const float* gsrc = F.in[10] + g * SGC + c0;
#pragma unroll
        for (int k = 0; k < 4; ++k) {
            const v4u raw = *(const v4u*)(src + 8 * k); const f32x4 g0 = *(const f32x4*)(gsrc + 8 * k), g1 = *(const f32x4*)(gsrc + 8 * k + 4);
            const float v[8] = {bflo(raw.x) * r_ * g0[0], bfhi(raw.x) * r_ * g0[1], bflo(raw.y) * r_ * g0[2], bfhi(raw.y) * r_ * g0[3],
                                bflo(raw.z) * r_ * g1[0], bfhi(raw.z) * r_ * g1[1], bflo(raw.w) * r_ * g1[2], bfhi(raw.w) * r_ * g1[3]};
#pragma unroll
            for (int e = 0; e < 8; e += 2) { const unsigned pk = pk2(v[e], v[e + 1]); VtT[(c0 + 8 * k + e) * SGU_PT + j] = (hbf)(pk & 0xffffu); VtT[(c0 + 8 * k + e + 1) * SGU_PT + j] = (hbf)(pk >> 16); }
        }
    }
    __syncthreads();
    const int r = lane_ & 15, q4 = lane_ >> 4, w = F.wave;
    const hbf* Wg = (const hbf*)(F.ws + WS_WSP) + (size_t)g * SGC * SGC;
#pragma unroll
    for (int half = 0; half < 2; ++half) {
        const int iw = half == 0 ? w : 7 - w, cb0 = 4 * half;
        const int nks = (16 * iw + 15) / 32 + 1;
        const int tok = tok0 + 16 * iw + r; const float bsv = F.in[12][g * SGC + 16 * iw + r];
        v2u uu[4];
#pragma unroll
        for (int cb = 0; cb < 4; ++cb) uu[cb] = *(const v2u*)(US + (size_t)tok * SGW + g * SGC + 16 * (cb0 + cb) + 4 * q4);
        f32x4 acc[4];
#pragma unroll
        for (int cb = 0; cb < 4; ++cb) acc[cb] = (f32x4){0.f, 0.f, 0.f, 0.f};
        for (int s_ = 0; s_ < nks; ++s_) {
            const bf16x8 bw = *(const bf16x8*)(Wg + (size_t)(16 * iw + r) * SGC + 32 * s_ + 8 * q4);
#pragma unroll
            for (int cb = 0; cb < 4; ++cb) {
                const bf16x8 av = *(const LAS bf16x8*)(VtT + (16 * (cb0 + cb) + r) * SGU_PT + 32 * s_ + 8 * q4);
                acc[cb] = MFMA16(av, bw, acc[cb]);
            }
        }
#pragma unroll
        for (int cb = 0; cb < 4; ++cb) {
            const size_t off = (size_t)tok * SGW + g * SGC + 16 * (cb0 + cb) + 4 * q4;
            v2u ov; ov.x = pk2(bflo(uu[cb].x) * (acc[cb][0] + bsv), bfhi(uu[cb].x) * (acc[cb][1] + bsv)); ov.y = pk2(bflo(uu[cb].y) * (acc[cb][2] + bsv), bfhi(uu[cb].y) * (acc[cb][3] + bsv));
            *(v2u*)(OB + off) = ov;
        }
    }
    __syncthreads();
}
__device__ __forceinline__ void sgu_sample_unit(const Frame& F, int u) {
    int tid_ = threadIdx.x; asm volatile("" : "+v"(tid_));
    LAS float* rs = (LAS float*)F.lds;
    const hbf* VS = (const hbf*)(F.ws + WS_VS); const hbf* US = (const hbf*)(F.ws + WS_US); hbf* OB = (hbf*)(F.ws + WS_OB);
    const int bb = u >> 3, g = u & 7, tok0 = MP + bb * DSEQ;
    if (tid_ < DSEQ) { const f32x4* p = (const f32x4*)((const float*)(F.ws + WS_VSSQ) + (size_t)(tok0 + tid_) * 16); float t = 0.f;
#pragma unroll
        for (int k = 0; k < 4; ++k) { const f32x4 q = p[k]; t += (q[0] + q[1]) + (q[2] + q[3]); }
        rs[tid_] = 1.0f / sqrtf(t * (1.0f / SGW) + EPS); }
    __syncthreads();
    const int c = g * SGC + (tid_ & 127), iq = __builtin_amdgcn_readfirstlane(tid_ >> 7);
    const float gain = F.in[10][c];
    float vn[DSEQ];
#pragma unroll
    for (int j = 0; j < DSEQ; ++j) vn[j] = __uint_as_float((unsigned)VS[(size_t)(tok0 + j) * SGW + c] << 16) * rs[j] * gain;
#pragma unroll
    for (int k = 0; k < 4; ++k) {
        const int i = iq + 4 * k;
        const float* wr = F.in[11] + ((size_t)g * SGC + i) * SGC;
        float mix = F.in[12][g * SGC + i], vi = 0.f;
#pragma unroll
        for (int j = 0; j < DSEQ; ++j) { const float wj = j <= i ? wr[j] : 0.f; mix += wj * vn[j]; vi = j == i ? vn[j] : vi; }
        const float uu = __uint_as_float((unsigned)US[(size_t)(tok0 + i) * SGW + c] << 16);
        OB[(size_t)(tok0 + i) * SGW + c] = (hbf)(pk2(uu * mix, 0.f) & 0xffffu);
        F.out[O_SGV + (size_t)(bb * DSEQ + i) * SGW + c] = vi;
    }
    __syncthreads();
}
#define CE_D(a, b) { const float h_ = fmaxf(a, b); b = fminf(a, b); a = h_; }
__device__ __forceinline__ void sort16_desc(float (&v)[16]) {
    CE_D(v[0], v[1])
    CE_D(v[3], v[2])
    CE_D(v[4], v[5])
    CE_D(v[7], v[6])
    CE_D(v[8], v[9])
    CE_D(v[11], v[10])
    CE_D(v[12], v[13])
    CE_D(v[15], v[14])
    CE_D(v[0], v[2])
    CE_D(v[1], v[3])
    CE_D(v[6], v[4])
    CE_D(v[7], v[5])
    CE_D(v[8], v[10])
    CE_D(v[9], v[11])
    CE_D(v[14], v[12])
    CE_D(v[15], v[13])
    CE_D(v[0], v[1])
    CE_D(v[2], v[3])
    CE_D(v[5], v[4])
    CE_D(v[7], v[6])
    CE_D(v[8], v[9])
    CE_D(v[10], v[11])
    CE_D(v[13], v[12])
    CE_D(v[15], v[14])
    CE_D(v[0], v[4])
    CE_D(v[1], v[5])
    CE_D(v[2], v[6])
    CE_D(v[3], v[7])
    CE_D(v[12], v[8])
    CE_D(v[13], v[9])
    CE_D(v[14], v[10])
    CE_D(v[15], v[11])
    CE_D(v[0], v[2])
    CE_D(v[1], v[3])
    CE_D(v[4], v[6])
    CE_D(v[5], v[7])
    CE_D(v[10], v[8])
    CE_D(v[11], v[9])
    CE_D(v[14], v[12])
    CE_D(v[15], v[13])
    CE_D(v[0], v[1])
    CE_D(v[2], v[3])
    CE_D(v[4], v[5])
    CE_D(v[6], v[7])
    CE_D(v[9], v[8])
    CE_D(v[11], v[10])
    CE_D(v[13], v[12])
    CE_D(v[15], v[14])
    CE_D(v[0], v[8])
    CE_D(v[1], v[9])
    CE_D(v[2], v[10])
    CE_D(v[3], v[11])
    CE_D(v[4], v[12])
    CE_D(v[5], v[13])
    CE_D(v[6], v[14])
    CE_D(v[7], v[15])
    CE_D(v[0], v[4])
    CE_D(v[1], v[5])
    CE_D(v[2], v[6])
    CE_D(v[3], v[7])
    CE_D(v[8], v[12])
    CE_D(v[9], v[13])
    CE_D(v[10], v[14])
    CE_D(v[11], v[15])
    CE_D(v[0], v[2])
    CE_D(v[1], v[3])
    CE_D(v[4], v[6])
    CE_D(v[5], v[7])
    CE_D(v[8], v[10])
    CE_D(v[9], v[11])
    CE_D(v[12], v[14])
    CE_D(v[13], v[15])
    CE_D(v[0], v[1])
    CE_D(v[2], v[3])
    CE_D(v[4], v[5])
    CE_D(v[6], v[7])
    CE_D(v[8], v[9])
    CE_D(v[10], v[11])
    CE_D(v[12], v[13])
    CE_D(v[14], v[15])
}
__device__ __forceinline__ void merge_top16(float (&a)[16], const float (&b)[16]) {
#pragma unroll
    for (int i = 0; i < 16; ++i) a[i] = fmaxf(a[i], b[15 - i]);
    CE_D(a[0], a[8])
    CE_D(a[1], a[9])
    CE_D(a[2], a[10])
    CE_D(a[3], a[11])
    CE_D(a[4], a[12])
    CE_D(a[5], a[13])
    CE_D(a[6], a[14])
    CE_D(a[7], a[15])
    CE_D(a[0], a[4])
    CE_D(a[1], a[5])
    CE_D(a[2], a[6])
    CE_D(a[3], a[7])
    CE_D(a[8], a[12])
    CE_D(a[9], a[13])
    CE_D(a[10], a[14])
    CE_D(a[11], a[15])
    CE_D(a[0], a[2])
    CE_D(a[1], a[3])
    CE_D(a[4], a[6])
    CE_D(a[5], a[7])
    CE_D(a[8], a[10])
    CE_D(a[9], a[11])
    CE_D(a[12], a[14])
    CE_D(a[13], a[15])
    CE_D(a[0], a[1])
    CE_D(a[2], a[3])
    CE_D(a[4], a[5])
    CE_D(a[6], a[7])
    CE_D(a[8], a[9])
    CE_D(a[10], a[11])
    CE_D(a[12], a[13])
    CE_D(a[14], a[15])
}
__device__ __forceinline__ void ins16(float (&T)[16], float x) {
#pragma unroll
    for (int t = 0; t < 16; ++t) { const float hi_ = fmaxf(T[t], x); x = fminf(T[t], x); T[t] = hi_; }
}
constexpr int PK_PT = 136;
__device__ __forceinline__ void peer_half_top16(const hbf* qrow, const LAS hbf* keys, int r32, int hi, float (&T)[16]) {
    bf16x8 qf[8];
#pragma unroll
    for (int ks = 0; ks < 8; ++ks) qf[ks] = *(const bf16x8*)(qrow + ks * 16 + hi * 8);
    bf16x8 ka[8], kn[8];
#pragma unroll
    for (int ks = 0; ks < 8; ++ks) ka[ks] = *(const LAS bf16x8*)(keys + r32 * PK_PT + ks * 16 + hi * 8);
#pragma unroll 1
    for (int kb = 0; kb < 4; ++kb) {
        const int kbn = kb < 3 ? kb + 1 : 3;
#pragma unroll
        for (int ks = 0; ks < 8; ++ks) kn[ks] = *(const LAS bf16x8*)(keys + (kbn * 32 + r32) * PK_PT + ks * 16 + hi * 8);
        f32x16 acc;
#pragma unroll
        for (int i = 0; i < 16; ++i) acc[i] = 0.f;
#pragma unroll
        for (int ks = 0; ks < 8; ++ks) acc = MFMA32(ka[ks], qf[ks], acc);
        float g[16];
#pragma unroll
        for (int i = 0; i < 16; ++i) { const int key = kb * 32 + (i & 3) + 8 * (i >> 2) + 4 * hi; g[i] = __uint_as_float((__float_as_uint(acc[i]) & ~127u) | (unsigned)key); }
        sort16_desc(g);
        if (kb == 0) {
#pragma unroll
            for (int t = 0; t < 16; ++t) T[t] = g[t];
        } else merge_top16(T, g);
#pragma unroll
        for (int ks = 0; ks < 8; ++ks) ka[ks] = kn[ks];
    }
    float oth[16];
#pragma unroll
    for (int t = 0; t < 16; ++t) oth[t] = __shfl_xor(T[t], 32);
    merge_top16(T, oth);
}
__device__ __forceinline__ void peer_topk_unit(const Frame& F, int unit) {
    const int pm = unit >> 3, h = unit & 7, r32 = F.lane & 31, hi = F.lane >> 5;
    const int tok = pm * 256 + F.wave * 32 + r32;
    const hbf* qrow = (const hbf*)(F.ws + WS_QN) + (size_t)tok * DM + h * PED;
    const hbf* sk = (const hbf*)(F.ws + WS_SK) + (size_t)h * 2 * PEK * 128;
    LAS hbf* KL = (LAS hbf*)F.lds;
    __syncthreads();
    for (int i = F.tid; i < 2 * PEK * 16; i += NTHREADS) { const int row = i >> 4, c = i & 15; *(LAS v4u*)(KL + row * PK_PT + c * 8) = *(const v4u*)(sk + (size_t)row * 128 + c * 8); }
    __syncthreads();
    float A[16], B[16];
    peer_half_top16(qrow, KL, r32, hi, A);
    peer_half_top16(qrow + 128, KL + PEK * PK_PT, r32, hi, B);
#define CAND(a, b) __uint_as_float((__float_as_uint(__uint_as_float(__float_as_uint(A[a]) & ~127u) + __uint_as_float(__float_as_uint(B[b]) & ~127u)) & ~255u) | (unsigned)((a) * 16 + (b)))
    float C[16], M[16];
#pragma unroll
    for (int b = 0; b < 16; ++b) C[b] = CAND(0, b);
#pragma unroll
    for (int b = 0; b < 8; ++b) { M[b] = CAND(1, b); M[8 + b] = CAND(15 - b, 0); }
    CE_D(M[0], M[8]) CE_D(M[1], M[9]) CE_D(M[2], M[10]) CE_D(M[3], M[11]) CE_D(M[4], M[12]) CE_D(M[5], M[13]) CE_D(M[6], M[14]) CE_D(M[7], M[15])
    CE_D(M[0], M[4]) CE_D(M[1], M[5]) CE_D(M[2], M[6]) CE_D(M[3], M[7]) CE_D(M[8], M[12]) CE_D(M[9], M[13]) CE_D(M[10], M[14]) CE_D(M[11], M[15])
    CE_D(M[0], M[2]) CE_D(M[1], M[3]) CE_D(M[4], M[6]) CE_D(M[5], M[7]) CE_D(M[8], M[10]) CE_D(M[9], M[11]) CE_D(M[12], M[14]) CE_D(M[13], M[15])
    CE_D(M[0], M[1]) CE_D(M[2], M[3]) CE_D(M[4], M[5]) CE_D(M[6], M[7]) CE_D(M[8], M[9]) CE_D(M[10], M[11]) CE_D(M[12], M[13]) CE_D(M[14], M[15])
    merge_top16(C, M);
    M[0] = CAND(2, 0); M[1] = CAND(2, 1); M[2] = CAND(2, 2); M[3] = CAND(2, 3); M[4] = CAND(2, 4); M[5] = CAND(3, 0); M[6] = CAND(3, 1); M[7] = CAND(3, 2); M[8] = CAND(3, 3);
    M[9] = CAND(4, 0); M[10] = CAND(4, 1); M[11] = CAND(4, 2); M[12] = CAND(5, 0); M[13] = CAND(5, 1); M[14] = CAND(6, 0); M[15] = CAND(6, 1);
    sort16_desc(M);
    merge_top16(C, M);
    ins16(C, CAND(7, 0)); ins16(C, CAND(7, 1));
#undef CAND
    float e[16], sum = 0.f; const float c0 = __uint_as_float(__float_as_uint(C[0]) & ~255u);
#pragma unroll
    for (int t = 0; t < 16; ++t) { e[t] = __builtin_amdgcn_exp2f((__uint_as_float(__float_as_uint(C[t]) & ~255u) - c0) * LOG2E); sum += e[t]; }
    const float inv = 1.0f / sum;
    unsigned pa[4], pb[4];
#pragma unroll
    for (int w = 0; w < 4; ++w) {
        pa[w] = (__float_as_uint(A[4 * w]) & 127u) | ((__float_as_uint(A[4 * w + 1]) & 127u) << 8) | ((__float_as_uint(A[4 * w + 2]) & 127u) << 16) | ((__float_as_uint(A[4 * w + 3]) & 127u) << 24);
        pb[w] = (__float_as_uint(B[4 * w]) & 127u) | ((__float_as_uint(B[4 * w + 1]) & 127u) << 8) | ((__float_as_uint(B[4 * w + 2]) & 127u) << 16) | ((__float_as_uint(B[4 * w + 3]) & 127u) << 24);
    }
    int ei[16];
#pragma unroll
    for (int t = 0; t < 16; ++t) {
        const unsigned code = __float_as_uint(C[t]) & 255u, ca = code >> 4, cb = code & 15u;
        const unsigned wa = (ca >> 2) == 0 ? pa[0] : (ca >> 2) == 1 ? pa[1] : (ca >> 2) == 2 ? pa[2] : pa[3];
        const unsigned wb = (cb >> 2) == 0 ? pb[0] : (cb >> 2) == 1 ? pb[1] : (cb >> 2) == 2 ? pb[2] : pb[3];
        const unsigned i1 = (wa >> ((ca & 3u) * 8u)) & 127u, i2 = (wb >> ((cb & 3u) * 8u)) & 127u;
        ei[t] = (int)(i1 * PEK + i2); e[t] *= inv;
    }
    if (hi == 0) {
        int* eo = (int*)(F.ws + WS_EI) + ((size_t)tok * PEH + h) * 16; float* go = (float*)(F.ws + WS_GW) + ((size_t)tok * PEH + h) * 16;
#pragma unroll
        for (int t = 0; t < 16; t += 4) { *(int4*)(eo + t) = make_int4(ei[t], ei[t + 1], ei[t + 2], ei[t + 3]); *(f32x4*)(go + t) = (f32x4){e[t], e[t + 1], e[t + 2], e[t + 3]}; }
    }
}

typedef float f32x2_ __attribute__((ext_vector_type(2)));
typedef int v8i_ __attribute__((ext_vector_type(8)));
constexpr float PEER_SU = 64.f, PEER_SV = 16.f;
__device__ __forceinline__ void peer_gather_token_x(const Frame& F0, int tok, const bool SPLIT) {
    Frame F = F0; { int t_ = threadIdx.x; asm volatile("" : "+v"(t_)); F.tid = t_; F.lane = t_ & 63; }
    const unsigned char* TU = (const unsigned char*)(F.ws + WS_TU); const unsigned char* TV = (const unsigned char*)(F.ws + WS_TV);
    const int r16 = F.lane & 15, q4 = F.lane >> 4;
    LAS unsigned char* xl = F.lds + F.wave * DM;
    {
        const hbf* xg = (const hbf*)(F.ws + WS_XG) + (size_t)tok * DM + 32 * F.lane; const float* gf = F.in[16] + 32 * F.lane;
        v4u o[2];
#pragma unroll
        for (int c = 0; c < 4; ++c) { const v4u w = *(const v4u*)(xg + 8 * c); const f32x4 ga = *(const f32x4*)(gf + 8 * c), gb = *(const f32x4*)(gf + 8 * c + 4);
            int p0 = 0, p1 = 0;
            p0 = __builtin_amdgcn_cvt_pk_fp8_f32(bflo(w.x) * ga[0], bfhi(w.x) * ga[1], p0, false); p0 = __builtin_amdgcn_cvt_pk_fp8_f32(bflo(w.y) * ga[2], bfhi(w.y) * ga[3], p0, true);
            p1 = __builtin_amdgcn_cvt_pk_fp8_f32(bflo(w.z) * gb[0], bfhi(w.z) * gb[1], p1, false); p1 = __builtin_amdgcn_cvt_pk_fp8_f32(bflo(w.w) * gb[2], bfhi(w.w) * gb[3], p1, true);
            o[c >> 1][2 * (c & 1)] = (unsigned)p0; o[c >> 1][2 * (c & 1) + 1] = (unsigned)p1; }
        *(LAS v4u*)(xl + 32 * F.lane) = o[0]; *(LAS v4u*)(xl + 32 * F.lane + 16) = o[1];
    }
    float t = (F.lane < 32) ? ((const float*)(F.ws + WS_XSSQ))[(size_t)tok * 32 + F.lane] : 0.f;
    const float rstd = (1.0f / PEER_SU) / sqrtf(wave_sum_dpp(t) * (1.0f / DM) + EPS);
    const int* ei = (const int*)(F.ws + WS_EI) + (size_t)tok * 128; const float* gw = (const float*)(F.ws + WS_GW) + (size_t)tok * 128;
#ifdef PROBE_P7MASK
    const int pm_ = F0.probe ? PROBE_P7MASK : 0xffffff; const int e0 = ei[F.lane] & pm_, e1 = ei[64 + F.lane] & pm_;
#else
    const int e0 = ei[F.lane], e1 = ei[64 + F.lane];
#endif
    const float g0 = gw[F.lane] * (1.0f / PEER_SV), g1 = gw[64 + F.lane] * (1.0f / PEER_SV);
    f32x2_ acc2[16];
#pragma unroll
    for (int i = 0; i < 16; ++i) acc2[i] = (f32x2_){0.f, 0.f};
    asm volatile("s_waitcnt lgkmcnt(0)" ::: "memory");
#define FP4_ACC(V, k, bsel) { const f32x2_ p = __builtin_amdgcn_cvt_scalef32_pk_f32_fp4(V[k], 1.0f, bsel); acc2[4 * (k) + (bsel)] = __builtin_elementwise_fma(p, w2, acc2[4 * (k) + (bsel)]); }
#define PG_ACC(V, m0) do { _Pragma("unroll") for (int m = 0; m < 8; ++m) { \
        const float wm = __builtin_bit_cast(float, __builtin_amdgcn_readlane(__builtin_bit_cast(int, wl), (m0) + m)); const f32x2_ w2 = {wm, wm}; \
        _Pragma("unroll") for (int k = 0; k < 4; ++k) { FP4_ACC(V[m], k, 0) FP4_ACC(V[m], k, 1) FP4_ACC(V[m], k, 2) FP4_ACC(V[m], k, 3) } } } while (0)
#pragma unroll 1
    for (int b = SPLIT ? F.wave : 0; b < (SPLIT ? F.wave + 1 : 8); ++b) {
        const int esrc = b < 4 ? e0 : e1; const float gsrc = b < 4 ? g0 : g1; const int lb = 16 * (b & 3);
        const int erA = __shfl(esrc, lb + (r16 & 7)), erB = __shfl(esrc, lb + 8 + (r16 & 7));
        v4u ua[16], vr[8], vs[8];
        const unsigned char* upA = TU + (size_t)erA * (DM / 2) + 64 * (r16 >> 3) + 16 * q4; const unsigned char* upB = TU + (size_t)erB * (DM / 2) + 64 * (r16 >> 3) + 16 * q4;
#pragma unroll
        for (int j = 0; j < 8; ++j) { ua[j] = *(const v4u*)(upA + 128 * j); ua[8 + j] = *(const v4u*)(upB + 128 * j); }
#pragma unroll
        for (int m = 0; m < 8; ++m) { const int e = __builtin_amdgcn_readlane(esrc, lb + m); vr[m] = *(const v4u*)(TV + (size_t)e * (DM / 2) + 16 * F.lane); }
        f32x4 z0 = {0.f, 0.f, 0.f, 0.f}, z1 = {0.f, 0.f, 0.f, 0.f};
        const LAS unsigned char* xa = xl + (r16 == 1 ? 128 : 0) + 16 * q4;
#pragma unroll
        for (int j = 0; j < 8; ++j) {
            const v4u x0 = *(const LAS v4u*)(xa + 256 * j), x1 = *(const LAS v4u*)(xa + 256 * j + 64);
            const v8i_ Ax = {(int)x0.x, (int)x0.y, (int)x0.z, (int)x0.w, (int)x1.x, (int)x1.y, (int)x1.z, (int)x1.w};
            const v8i_ Ba = {(int)ua[j].x, (int)ua[j].y, (int)ua[j].z, (int)ua[j].w, 0, 0, 0, 0}, Bb = {(int)ua[8 + j].x, (int)ua[8 + j].y, (int)ua[8 + j].z, (int)ua[8 + j].w, 0, 0, 0, 0};
            z0 = __builtin_amdgcn_mfma_scale_f32_16x16x128_f8f6f4(Ax, Ba, z0, 0  , 4  , 0, 0x7f7f7f7f, 0, 0x7f7f7f7f);
            z1 = __builtin_amdgcn_mfma_scale_f32_16x16x128_f8f6f4(Ax, Bb, z1, 0, 4, 0, 0x7f7f7f7f, 0, 0x7f7f7f7f);
            if ((j & 1) == 1) __builtin_amdgcn_sched_barrier(0);
        }
#pragma unroll
        for (int m = 0; m < 8; ++m) { const int e = __builtin_amdgcn_readlane(esrc, lb + 8 + m); vs[m] = *(const v4u*)(TV + (size_t)e * (DM / 2) + 16 * F.lane); }
        const int n7 = r16 & 7;
        const float za = __shfl(z0[0], n7) + __shfl(z0[1], n7 + 8), zb = __shfl(z1[0], n7) + __shfl(z1[1], n7 + 8);
        const float wl = __shfl(gsrc, lb + r16) * gelu_tanh((r16 < 8 ? za : zb) * rstd);
#ifdef PROBE_P7NOACC
        if (F0.probe) { unsigned xx = 0;
#pragma unroll
            for (int m = 0; m < 8; ++m) xx ^= (vr[m].x ^ vr[m].y ^ vr[m].z ^ vr[m].w) ^ (vs[m].x ^ vs[m].y ^ vs[m].z ^ vs[m].w);
            acc2[0].x += __uint_as_float(xx & 0xff) * wl; }
        else
#endif
        { PG_ACC(vr, 0);
        PG_ACC(vs, 8); }
    }
#undef PG_ACC
#undef FP4_ACC
    if (SPLIT) {
        LAS float* pbase = (LAS float*)(F.lds + 32768);
        LAS float* part = pbase + F.wave * DM + 32 * F.lane;
#pragma unroll
        for (int k = 0; k < 8; ++k) *(LAS f32x4*)(part + 4 * k) = (f32x4){acc2[2 * k].x, acc2[2 * k].y, acc2[2 * k + 1].x, acc2[2 * k + 1].y};
        __syncthreads();
        const int c0 = 4 * F.tid;
        f32x4 sacc = {0.f, 0.f, 0.f, 0.f};
#pragma unroll
        for (int w = 0; w < NWAVES; ++w) sacc += *(const LAS f32x4*)(pbase + w * DM + c0);
        const v2u xb = *(const v2u*)((const hbf*)(F.ws + WS_XG) + (size_t)tok * DM + c0);
        sacc += (f32x4){bflo(xb.x), bfhi(xb.x), bflo(xb.y), bfhi(xb.y)};
        *(f32x4*)(F.out + O_Y + (size_t)tok * DM + c0) = sacc;
        __syncthreads();
        return;
    }
#ifdef PROBE_P7MASK
    float* orow = (F0.probe ? (float*)(F.ws + WS_H) : F.out + O_Y) + (size_t)tok * DM + 32 * F.lane;
#else
    float* orow = F.out + O_Y + (size_t)tok * DM + 32 * F.lane;
#endif
    const hbf* xrow1 = (const hbf*)(F.ws + WS_XG) + (size_t)tok * DM + 32 * F.lane;
#pragma unroll
    for (int k = 0; k < 4; ++k) { const v4u w = *(const v4u*)(xrow1 + 8 * k);
        const f32x4 a = (f32x4){bflo(w.x), bfhi(w.x), bflo(w.y), bfhi(w.y)} + (f32x4){acc2[4 * k].x, acc2[4 * k].y, acc2[4 * k + 1].x, acc2[4 * k + 1].y};
        const f32x4 b = (f32x4){bflo(w.z), bfhi(w.z), bflo(w.w), bfhi(w.w)} + (f32x4){acc2[4 * k + 2].x, acc2[4 * k + 2].y, acc2[4 * k + 3].x, acc2[4 * k + 3].y};
        *(f32x4*)(orow + 8 * k) = a; *(f32x4*)(orow + 8 * k + 4) = b; }
}
#ifndef MK_LAUNCHES
#define MK_LAUNCHES 1
#endif
constexpr int NPHASE = 8;
struct Args { const float* in[22]; float* out; unsigned char* ws; int ph_lo, ph_hi, attn_w, attn_skv, q_lo, q_hi; };

__global__ void __launch_bounds__(NTHREADS, 2) fox_sgu_peer_fwd(Args args) {
    extern __shared__ __attribute__((aligned(16))) unsigned char lds[];
#define MKFRAME() Frame F; { int t_ = threadIdx.x; asm volatile("" : "+v"(t_)); F.lds = (LAS unsigned char*)lds; F.lds_g = lds; F.tid = t_; F.lane = t_ & 63; F.wave = __builtin_amdgcn_readfirstlane(t_ >> 6); \
        F.G = gridDim.x; F.probe = args.q_lo == 999; const int bx_ = blockIdx.x; F.vcu = (F.G % 8 == 0) ? (bx_ % 8) * (F.G / 8) + bx_ / 8 : bx_; F.in = args.in; unsigned long long w_ = (unsigned long long)args.ws, o_ = (unsigned long long)args.out; asm volatile("" : "+s"(w_), "+s"(o_)); F.out = (float*)(GAS float*)o_; F.ws = (unsigned char*)(GAS unsigned char*)w_; } \
        unsigned char* ws = F.ws; LAS float* stat = (LAS float*)(F.lds + LDS_STAT); (void)stat; (void)ws
    const int lo = args.ph_lo, hi = args.ph_hi;
#ifndef PH_MASK
#define PH_MASK 0xff
#endif
#define IN(k) (((PH_MASK >> (k)) & 1) && lo <= (k) && (k) < hi)
#if MK_LAUNCHES == 1
    volatile LAS unsigned* xb_st = (volatile LAS unsigned*)((LAS unsigned char*)lds + LDS_XB);
    if (threadIdx.x == 0) { xb_st[0] = 0u; xb_st[1] = 0u; }
    __syncthreads();
    (void)xcd_barrier_post((unsigned*)(args.ws + WS_CTL) + CW_BAR, xb_st);
#define XBAR() do { XcdBarrier bar_; bar_.bar = (unsigned*)(args.ws + WS_CTL) + CW_BAR; bar_.x = xb_xcc_id(); bar_.st = xb_st; xcd_barrier(bar_); } while (0)
#define SEAM(k) do { if (IN(k) && IN((k) + 1)) XBAR(); } while (0)
#else
#define XBAR() do { } while (0)
#define SEAM(k) do { } while (0)
#endif
#ifndef PROBE_REP
#define PROBE_REP (-1)
#endif
#define REPS(k) for (int rep_ = 0; rep_ < ((PROBE_REP == (k)) ? 2 : 1); ++rep_)

    if (lo < 0) cooperative_groups::this_grid().sync();
    if (IN(0)) REPS(0) { if (rep_) XBAR(); MKFRAME(); phase0(F); __syncthreads(); }
    SEAM(0);
    if (IN(1)) REPS(1) {
        if (rep_) XBAR();
        MKFRAME();
        for (int u = blockIdx.x; u < NBATCH + DBATCH; u += F.G) phase1_scan(F, u);
#ifndef P1_SKEW_NUM
#define P1_SKEW_NUM 0
#endif
#ifndef P1_SKEW_GROUPS
#define P1_SKEW_GROUPS 2
#endif
        constexpr size_t CV_ALL = (size_t)NEXP * DM / 32, CV_UNIT = CV_ALL * P1_SKEW_NUM / 100 / 512 * 512;
        constexpr int SKG = 4;
        const bool skew = F.G == 256 && P1_SKEW_NUM > 0;
        if (P0_LATE_OK(F) && (blockIdx.x & 4) && blockIdx.x >= 40) { late_weights(F, (LAS float*)(F.lds + F.wave * 8448), (int)((((blockIdx.x - 40) >> 3) << 2) | (blockIdx.x & 3)) * NWAVES + F.wave, 108 * NWAVES); __syncthreads(); }
        if (skew && blockIdx.x >= 40) { const int xcd = blockIdx.x & 7, g = xcd & 3;
            if (g) convert_tables(F, (int)((((blockIdx.x - 40) >> 3) << 1) | (xcd >> 2)), 54, CV_UNIT * (size_t)(g * (g - 1) / 2), CV_UNIT * (size_t)(g * (g + 1) / 2)); }
        const size_t cv_lo = skew ? CV_UNIT * (size_t)(SKG * (SKG - 1) / 2) : 0;
        pg8::Gemm g{(const pg8::bf16_t*)(ws + WS_H), (const pg8::bf16_t*)(ws + WS_WIN), MT, NZ, DM};
        pg8::StaticOrder S; S.init(MT, NZ, F.G, (int)blockIdx.x);
        EpiIn E{(hbf*)(ws + WS_Q), (hbf*)(ws + WS_QS), (hbf*)(ws + WS_K), (hbf*)(ws + WS_V), (hbf*)(ws + WS_US), (hbf*)(ws + WS_VS), (hbf*)(ws + WS_GA), (hbf*)(ws + WS_GB),
                F.out, (float*)(ws + WS_VSSQ), F.in[8], F.in[9], stat, args.q_lo == 777 ? 1 : 0};
        pg8::gemm_phase<EpiIn, pg8::StaticOrder, true, true>(F.lds, g, S, E);
        __syncthreads();
        { const int nlast = (MT / 256) * (NZ / 256) % F.G;
#ifdef CV_STATIC
          if (nlast == 0 || nlast * 2 > F.G) convert_tables(F, (int)blockIdx.x, F.G, cv_lo); else if ((int)blockIdx.x >= nlast) convert_tables(F, (int)blockIdx.x - nlast, F.G - nlast, cv_lo); }
#else
          (void)nlast; convert_tables_dyn(F, cv_lo); }
#endif
    }
    SEAM(1);
#ifdef NO_AS
#define AS_CALL(u) do { } while (0)
#else
#define AS_CALL(u) attn_sample_unit(F, u)
#endif
#ifdef NO_SGU
#define SGU_CALL(u) do { } while (0)
#else
#define SGU_CALL(u) do { } while (0)
#endif
    if (IN(2)) REPS(2) {
        if (rep_) XBAR();
        MKFRAME();
        {
            using namespace attn;
            const float thr_raw = attn_skip_threshold(F);
            char* ldsg = (char*)F.lds_g; float* bias_lds = (float*)(ldsg + ATT_BIAS_OFF);
            int item = p2_pop(F);
            const int qlo_ = args.q_lo, qhi_ = args.q_hi;
            while (item < Q_SAMPLE) { if (item >= qlo_ && item < qhi_) attn_sample_unit(F, item); item = p2_pop(F); }
            while (item < Q_SAMPLE + Q_PROMPT) {
                if (item < qlo_ || item >= qhi_) { item = p2_pop(F); continue; }
                const BlockRef<bf16, bf16> cur = attn_prompt_ref(F, item - Q_SAMPLE, thr_raw);
                Seam<bf16> S;
                causal_swa_prime<bf16, bf16>(cur, args.attn_w, ldsg, S);
                causal_swa_block<bf16, bf16>(cur, cur, args.attn_skv, args.attn_w, ldsg, S, bias_lds);
                item = p2_pop(F);
            }
#define P2_POP_AHEAD(CALL) do { unsigned nx_ = 0; if (F.tid == 0) nx_ = atomicAdd((unsigned*)(ws + WS_CTL) + CW_Q, 1u); CALL; \
        LAS int* slot_ = (LAS int*)(F.lds + LDS_POP) + 1; if (F.tid == 0) *slot_ = (int)nx_; __syncthreads(); item = __builtin_amdgcn_readfirstlane(*slot_); __syncthreads(); } while (0)
            while (item < Q_SGP) P2_POP_AHEAD(sgu_sample_unit(F, item - Q_SGS));
            while (item < Q_END) P2_POP_AHEAD(sgu_prompt_unit(F, item - Q_SGP));
#undef P2_POP_AHEAD
        }
    }
    SEAM(2);
    const bool whole = (lo <= 3 && hi >= 8 && ((PH_MASK >> 3) & 0x1f) == 0x1f) && gridDim.x > NCHAIN;
    const int ci = (int)blockIdx.x - ((int)gridDim.x - NCHAIN);
    {
        const int ntm = whole ? (false ? 1 : NTM - 1) : NTM;
#define PSEAM(k) SEAM(k)
        if (IN(3)) {
            MKFRAME();
            pg8::Gemm g{(const pg8::bf16_t*)(ws + WS_OA), (const pg8::bf16_t*)(ws + WS_WAB), 2 * MT, 2 * DM, FW};
            MergeOrder S{false ? NCHAIN : F.G, false ? ci : (int)blockIdx.x, false ? (NTM - 1) * 8 : 0, ntm * 8 + (false ? (NTM - 1) * 8 : 0)};
            EpiMerge E{(const hbf*)(ws + WS_GA), (const hbf*)(ws + WS_GB), (hbf*)(ws + WS_Y)};
            pg8::gemm_phase<EpiMerge, MergeOrder, true, true>(F.lds, g, S, E);
            __syncthreads();
        }
        PSEAM(3);
        if (IN(4)) {
            MKFRAME();
            pg8::Gemm g{(const pg8::bf16_t*)(ws + WS_Y), (const pg8::bf16_t*)(ws + WS_WO), MT, DM, DM};
            TileOrder S; S.so.init(ntm * 256, DM, F.G, (int)blockIdx.x); S.chain = false; S.ci = ci;
            EpiOut E{(const hbf*)(ws + WS_H), (const float*)(ws + WS_RS0), (hbf*)(ws + WS_XG), (float*)(ws + WS_XSSQ)};
            pg8::gemm_phase<EpiOut, TileOrder, true, true>(F.lds, g, S, E);
            __syncthreads();
        }
        PSEAM(4);
        if (IN(5)) {
            MKFRAME();
            pg8::Gemm g{(const pg8::bf16_t*)(ws + WS_XG), (const pg8::bf16_t*)(ws + WS_WPQ), MT, DM, DM};
            TileOrder S; S.so.init(ntm * 256, DM, F.G, (int)blockIdx.x); S.chain = false; S.ci = ci;
            EpiPeerQ E{(const float*)(ws + WS_XSSQ), F.in[18], (hbf*)(ws + WS_QN), stat};
            pg8::gemm_phase<EpiPeerQ, TileOrder, true, true>(F.lds, g, S, E);
            asm volatile("s_waitcnt vmcnt(0)" ::: "memory"); __syncthreads();
            if (IN(6)) { pg8::Unit u_; for (int i = 0; S.next(i, u_); ++i) peer_topk_unit(F, u_.pm * PEH + u_.pn); }
        }
        else if (IN(6)) { MKFRAME(); for (int u = blockIdx.x; u < ntm * PEH; u += F.G) peer_topk_unit(F, u); }
        PSEAM(6);
#undef PSEAM
    }
    if (whole && ci >= 0) {
        const int ntm = whole ? (true ? 1 : NTM - 1) : NTM;
        unsigned chain_round = 0u;
#define PSEAM(k) do { chain_barrier((unsigned*)(args.ws + WS_CTL) + CW_CHAIN, chain_round); ++chain_round; } while (0)
        if (IN(3)) {
            MKFRAME();
            pg8::Gemm g{(const pg8::bf16_t*)(ws + WS_OA), (const pg8::bf16_t*)(ws + WS_WAB), 2 * MT, 2 * DM, FW};
            MergeOrder S{true ? NCHAIN : F.G, true ? ci : (int)blockIdx.x, true ? (NTM - 1) * 8 : 0, ntm * 8 + (true ? (NTM - 1) * 8 : 0)};
            EpiMerge E{(const hbf*)(ws + WS_GA), (const hbf*)(ws + WS_GB), (hbf*)(ws + WS_Y)};
            pg8::gemm_phase<EpiMerge, MergeOrder, true, true>(F.lds, g, S, E);
            __syncthreads();
        }
        PSEAM(3);
        if (IN(4)) {
            MKFRAME();
            pg8::Gemm g{(const pg8::bf16_t*)(ws + WS_Y), (const pg8::bf16_t*)(ws + WS_WO), MT, DM, DM};
            TileOrder S; S.so.init(ntm * 256, DM, F.G, (int)blockIdx.x); S.chain = true; S.ci = ci;
            EpiOut E{(const hbf*)(ws + WS_H), (const float*)(ws + WS_RS0), (hbf*)(ws + WS_XG), (float*)(ws + WS_XSSQ)};
            pg8::gemm_phase<EpiOut, TileOrder, true, true>(F.lds, g, S, E);
            __syncthreads();
        }
        PSEAM(4);
        if (IN(5)) {
            MKFRAME();
            pg8::Gemm g{(const pg8::bf16_t*)(ws + WS_XG), (const pg8::bf16_t*)(ws + WS_WPQ), MT, DM, DM};
            TileOrder S; S.so.init(ntm * 256, DM, F.G, (int)blockIdx.x); S.chain = true; S.ci = ci;
            EpiPeerQ E{(const float*)(ws + WS_XSSQ), F.in[18], (hbf*)(ws + WS_QN), stat};
            pg8::gemm_phase<EpiPeerQ, TileOrder, true, true>(F.lds, g, S, E);
            asm volatile("s_waitcnt vmcnt(0)" ::: "memory"); __syncthreads();
            if (IN(6)) peer_topk_unit(F, (NTM - 1) * PEH + ci);
        }
        PSEAM(6);
#undef PSEAM
    }
#ifndef P7_SPLIT_EXTRA
#define P7_SPLIT_EXTRA 0
#endif
    if (IN(7)) {
        MKFRAME();
#ifdef PROBE_MICRO
        if (F.probe) {
            unsigned x = (unsigned)F.tid * 2654435761u + 12345u; unsigned long long w2 = 0x3f8000003f800000ull; unsigned wh = 0x3c003c00u;
            unsigned long long a[16]; unsigned ah[16];
#pragma unroll
            for (int k = 0; k < 16; ++k) { a[k] = 0ull; ah[k] = 0u; }
#pragma unroll 1
            for (int it = 0; it < 4096; ++it) {
#pragma unroll
                for (int k = 0; k < 16; ++k) {
#if PROBE_MICRO == 1
                    unsigned long long p; asm volatile("v_cvt_scalef32_pk_f32_fp4 %0, %1, 1.0" : "=v"(p) : "v"(x)); asm volatile("v_pk_fma_f32 %0, %1, %2, %0" : "+v"(a[k]) : "v"(p), "v"(w2));
#elif PROBE_MICRO == 2
                    unsigned p; asm volatile("v_cvt_scalef32_pk_f16_fp4 %0, %1, 1.0" : "=v"(p) : "v"(x)); asm volatile("v_pk_fma_f16 %0, %1, %2, %0" : "+v"(ah[k]) : "v"(p), "v"(wh));
#elif PROBE_MICRO == 3
                    asm volatile("v_cvt_scalef32_pk_f32_fp4 %0, %1, 1.0" : "=v"(a[k]) : "v"(x));
#else
                    asm volatile("v_pk_fma_f32 %0, %1, %2, %0" : "+v"(a[k]) : "v"(w2), "v"(w2));
#endif
                }
                x = x * 1664525u + 1013904223u;
            }
            unsigned long long t = 0;
#pragma unroll
            for (int k = 0; k < 16; ++k) t += a[k] + ah[k];
            ((unsigned long long*)(ws + WS_H))[(size_t)blockIdx.x * NTHREADS + F.tid] = t;
        } else
#endif
        if (!whole) { const int gw = F.vcu * NWAVES + F.wave, NGW = F.G * NWAVES; for (int tok = gw; tok < MT; tok += NGW) peer_gather_token_x(F, tok, false); }
        else {
            const int NGW = (F.G - NCHAIN) * NWAVES, nfull = MP / NGW - P7_SPLIT_EXTRA;
            const int base = ci < 0 ? (int)blockIdx.x * NWAVES + F.wave : MP + ci * NWAVES + F.wave, step = ci < 0 ? NGW : NCHAIN * NWAVES, nmine = ci < 0 ? nfull : (MT - MP) / (NCHAIN * NWAVES);
            LAS int* slot = (LAS int*)(F.lds + LDS_POP); unsigned* ctr = (unsigned*)(ws + WS_CTL) + CW_P7;
            unsigned nx = 0;
            for (int k = 0; ; ++k) {
                const bool sp = k >= nmine;
                int tk = base + k * step;
                if (sp) { if (F.tid == 0) slot[k & 1] = (int)nx; __syncthreads(); tk = nfull * NGW + __builtin_amdgcn_readfirstlane(slot[k & 1]); if (tk >= MP) break; }
                if (k >= nmine - 1 && F.tid == 0) nx = atomicAdd(ctr, 1u);
                peer_gather_token_x(F, tk, sp);
            } }
    }
#undef IN
#undef SEAM
}

extern "C" void kernel_launch(void* const* d_in, const int* in_sizes, int n_in, void* d_out, int out_size, void* d_ws, size_t ws_size, hipStream_t stream) {
    static int grid = 0;
    if (grid == 0) {
        if (n_in != 22 || out_size != (int)O_END || ws_size < WS_END) { fprintf(stderr, "kernel_launch: unexpected shapes (n_in %d, out %d, ws %zu; need ws >= %zu); nothing launched\n", n_in, out_size, ws_size, (size_t)WS_END); grid = -1; return; }
        int dev = 0, cus = 0, per_cu = 0;
        if (hipGetDevice(&dev) != hipSuccess || hipDeviceGetAttribute(&cus, hipDeviceAttributeMultiprocessorCount, dev) != hipSuccess) { grid = -1; return; }
        if (hipFuncSetAttribute((const void*)fox_sgu_peer_fwd, hipFuncAttributeMaxDynamicSharedMemorySize, LDS_BYTES) != hipSuccess) { fprintf(stderr, "kernel_launch: hipFuncSetAttribute failed\n"); grid = -1; return; }
        if (hipOccupancyMaxActiveBlocksPerMultiprocessor(&per_cu, (const void*)fox_sgu_peer_fwd, NTHREADS, LDS_BYTES) != hipSuccess || per_cu < 1) { fprintf(stderr, "kernel_launch: occupancy query says %d workgroups per CU\n", per_cu); per_cu = 1; }
        (void)hipGetLastError();
        grid = cus * 1;
        if (grid > 256) grid = 256;
    }
    if (grid < 0) return;
#if MK_LAUNCHES == 1
    if (hipMemsetAsync((char*)d_ws + WS_CTL, 0, CTL_ZERO, stream) != hipSuccess) { fprintf(stderr, "kernel_launch: hipMemsetAsync failed\n"); return; }
#endif
    Args a{};
    for (int i = 0; i < 22; ++i) a.in[i] = (const float*)d_in[i];
    a.out = (float*)d_out; a.ws = (unsigned char*)d_ws; a.attn_w = 1 << 30; a.attn_skv = SEQ; a.q_lo = 0; a.q_hi = 1 << 30;
#if MK_LAUNCHES == 1
    a.ph_lo = 0; a.ph_hi = NPHASE;
    void* kargs[] = {&a};
    hipError_t e = hipLaunchCooperativeKernel((const void*)fox_sgu_peer_fwd, dim3(grid), dim3(NTHREADS), kargs, LDS_BYTES, stream);
    if (e != hipSuccess) fprintf(stderr, "kernel_launch: cooperative launch failed: %s (grid %d)\n", hipGetErrorString(e), grid);
#ifdef PROBE_PHASE
    a.ph_lo = PROBE_PHASE; a.ph_hi = PROBE_PHASE + 1;
#ifdef PROBE_QLO
    a.q_lo = PROBE_QLO; a.q_hi = PROBE_QHI;
#endif
    (void)hipMemsetAsync((char*)d_ws + WS_CTL + CW_Q * 4, 0, 256, stream);
    hipLaunchKernelGGL(fox_sgu_peer_fwd, dim3(grid), dim3(NTHREADS), LDS_BYTES, stream, a);
#endif
#else
    for (int p = 0; p < NPHASE; ++p) {
        a.ph_lo = p; a.ph_hi = p + 1;
        hipLaunchKernelGGL(fox_sgu_peer_fwd, dim3(grid), dim3(NTHREADS), LDS_BYTES, stream, a);
    }
#endif
}
```
